# Optimizing an MI355X kernel written in HIP

```python
import math
import jax, jax.numpy as jnp
from jax import lax
import numpy as np

D_MODEL = 1024
BATCH = 16
SEQ = 2048
DEPTH = 2

MIX_WIDTH = D_MODEL
MLA_WIDTH = D_MODEL // 2
SSM_WIDTH = MIX_WIDTH - MLA_WIDTH
V_HEAD = 64
N_HEADS = MLA_WIDTH // V_HEAD
QK_NOPE = 64
QK_ROPE = 32
Q_LORA = D_MODEL // 4
KV_LORA = D_MODEL // 8
ROPE_BASE = 10000.0
Q_BLOCK = 128
ATTN_SCALE = 1.0 / math.sqrt(QK_NOPE + QK_ROPE)
SSM_CH = 16
SSM_GROUPS = SSM_WIDTH // SSM_CH
SSM_STATE = 64
STEP_MIN = 0.001
STEP_MAX = 0.1
OFF_KV = Q_LORA
OFF_KR = OFF_KV + KV_LORA
OFF_SSM = OFF_KR + QK_ROPE
IN_WIDTH = OFF_SSM + SSM_WIDTH
N_EXPERT_GROUPS = 4
EXPERTS_PER_GROUP = 8
N_EXPERTS = N_EXPERT_GROUPS * EXPERTS_PER_GROUP
TOP_K = 2
D_EXPERT = D_MODEL // 4
DISPATCH_BLOCK = 128
PLE_DIM = 256
EPS = 1e-6

kernel_name = "hymba_mla_s5_hiermoe_ple"


def rmsnorm(x, g):
    xf = x.astype(jnp.float32)
    y = xf * lax.rsqrt(jnp.mean(xf * xf, axis=-1, keepdims=True) + EPS)
    return (y * g.astype(jnp.float32)).astype(x.dtype)


def rope_tables(positions):
    half = QK_ROPE // 2
    inv_freq = ROPE_BASE ** (-jnp.arange(half, dtype=jnp.float32) / half)
    ang = positions.astype(jnp.float32)[..., None] * inv_freq
    return jnp.cos(ang)[:, :, None, :], jnp.sin(ang)[:, :, None, :]


def apply_rope(x, cos, sin):
    half = QK_ROPE // 2
    xf = x.astype(jnp.float32)
    x1, x2 = xf[..., :half], xf[..., half:]
    return jnp.concatenate([x1 * cos - x2 * sin, x1 * sin + x2 * cos], axis=-1).astype(x.dtype)


def causal_attention(q, k, v):
    bsz, seq, heads, dqk = q.shape
    nb = seq // Q_BLOCK
    qb = q.reshape(bsz, nb, Q_BLOCK, heads, dqk).transpose(1, 0, 2, 3, 4)
    kpos = jnp.arange(seq)

    def one_block(args):
        qi, bi = args
        s = jnp.einsum('bqhd,bkhd->bhqk', qi, k).astype(jnp.float32) * ATTN_SCALE
        qpos = bi * Q_BLOCK + jnp.arange(Q_BLOCK)
        s = jnp.where(kpos[None, :] <= qpos[:, None], s, -1e30)
        pr = jax.nn.softmax(s, axis=-1).astype(v.dtype)
        return jnp.einsum('bhqk,bkhd->bqhd', pr, v)

    ob = lax.map(one_block, (qb, jnp.arange(nb)))
    return ob.transpose(1, 0, 2, 3, 4).reshape(bsz, seq, heads * v.shape[-1])


def mla_group(q_lat, kv_lat, k_rope_in, cos, sin, g_q, w_q_up, g_kv, w_kv_up):
    bsz, seq, _ = q_lat.shape
    q = (rmsnorm(q_lat, g_q) @ w_q_up).reshape(bsz, seq, N_HEADS, QK_NOPE + QK_ROPE)
    q = jnp.concatenate([q[..., :QK_NOPE], apply_rope(q[..., QK_NOPE:], cos, sin)], axis=-1)
    kv = (rmsnorm(kv_lat, g_kv) @ w_kv_up).reshape(bsz, seq, N_HEADS, QK_NOPE + V_HEAD)
    k_pe = apply_rope(k_rope_in[:, :, None, :], cos, sin)
    k = jnp.concatenate([kv[..., :QK_NOPE],
                         jnp.broadcast_to(k_pe, (bsz, seq, N_HEADS, QK_ROPE))], axis=-1)
    v = kv[..., QK_NOPE:]
    return causal_attention(q, k, v)


def _lin_rec_combine(e1, e2):
    a1, b1 = e1
    a2, b2 = e2
    return a2 * a1, a2 * b1 + b2


def s5_group(u, a_re, a_im, b_re, b_im, c_re, c_im, d, log_step, w_glu, b_glu):
    f32 = jnp.float32
    bsz, seq, _ = u.shape
    u32 = u.astype(f32).reshape(bsz, seq, SSM_GROUPS, SSM_CH)
    lam = lax.complex(a_re.astype(f32), a_im.astype(f32))
    delta = jnp.exp(log_step.astype(f32))[:, None]
    lam_bar = jnp.exp(lam * delta)
    b_fac = (lam_bar - 1.0) / lam
    bu = lax.complex(jnp.einsum('blgh,gph->blgp', u32, b_re.astype(f32)),
                     jnp.einsum('blgh,gph->blgp', u32, b_im.astype(f32))) * b_fac
    a = jnp.broadcast_to(lam_bar, (1, seq) + lam_bar.shape)
    _, states = lax.associative_scan(_lin_rec_combine, (a, bu), axis=1)
    y = (jnp.einsum('blgp,ghp->blgh', jnp.real(states), c_re.astype(f32))
         - jnp.einsum('blgp,ghp->blgh', jnp.imag(states), c_im.astype(f32))
         + d.astype(f32) * u32)
    y = jax.nn.gelu(y.reshape(bsz, seq, SSM_WIDTH))
    y = y * jax.nn.sigmoid(y @ w_glu.astype(f32) + b_glu.astype(f32))
    return y.astype(u.dtype)


def hier_moe(xn, w_gr, b_gr, w_er, b_er, w_g, w_u, w_d):
    bsz, seq, dm = xn.shape
    t = bsz * seq
    xf = xn.reshape(t, dm)
    g_prob = jax.nn.softmax((xf @ w_gr).astype(jnp.float32) + b_gr.astype(jnp.float32), axis=-1)
    g_top_p, g_top = lax.top_k(g_prob, 1)
    e_logits = ((xf @ w_er).astype(jnp.float32) + b_er.astype(jnp.float32)).reshape(t, N_EXPERT_GROUPS, EXPERTS_PER_GROUP)
    e_sel = jnp.take_along_axis(e_logits, g_top[:, :, None], axis=1)[:, 0]
    e_top_l, e_top = lax.top_k(e_sel, TOP_K)
    weights = g_top_p * jax.nn.softmax(e_top_l, axis=-1)
    expert_id = g_top * EXPERTS_PER_GROUP + e_top
    flat_e = expert_id.reshape(-1)
    flat_tok = jnp.repeat(jnp.arange(t, dtype=jnp.int32), TOP_K, total_repeat_length=t * TOP_K)
    flat_w = weights.reshape(-1)
    order = jnp.argsort(flat_e)
    se, stok, sw = flat_e[order], flat_tok[order], flat_w[order]
    counts = jnp.bincount(flat_e, length=N_EXPERTS)
    starts = jnp.cumsum(counts) - counts
    pcounts = (counts + DISPATCH_BLOCK - 1) // DISPATCH_BLOCK * DISPATCH_BLOCK
    pends = jnp.cumsum(pcounts)
    pstarts = pends - pcounts
    dest = pstarts[se] + (jnp.arange(t * TOP_K) - starts[se])
    n_slots = t * TOP_K + N_EXPERTS * DISPATCH_BLOCK
    n_blocks = n_slots // DISPATCH_BLOCK
    xbuf = jnp.zeros((n_slots, dm), xn.dtype).at[dest].set(xf[stok])
    block_e = jnp.minimum(jnp.searchsorted(pends, jnp.arange(n_blocks) * DISPATCH_BLOCK, side='right'),
                          N_EXPERTS - 1)

    def expert_block(args):
        xb, e = args
        hdn = jax.nn.silu(xb @ w_g[e]) * (xb @ w_u[e])
        return hdn @ w_d[e]

    ybuf = lax.map(expert_block, (xbuf.reshape(n_blocks, DISPATCH_BLOCK, dm), block_e)).reshape(n_slots, dm)
    y = jax.ops.segment_sum(ybuf[dest] * sw[:, None].astype(xn.dtype), stok, num_segments=t)
    return y.reshape(bsz, seq, dm)


def setup_inputs(seed: int = 0) -> dict:
    key = jax.random.key(seed)
    ks = jax.random.split(key, 40)
    nrm = lambda k, shape, s: jax.random.normal(k, shape, jnp.float32) * s
    gain = lambda k, n: 1.0 + 0.01 * jax.random.normal(k, (DEPTH, n), jnp.float32)
    L = DEPTH
    a_im = jnp.pi * jnp.arange(SSM_STATE, dtype=jnp.float32)
    return {
        "x": nrm(ks[0], (BATCH, SEQ, D_MODEL), 1.0),
        "p": nrm(ks[1], (DEPTH, BATCH, SEQ, PLE_DIM), 1.0),
        "positions": jnp.broadcast_to(jnp.arange(SEQ, dtype=jnp.int32), (BATCH, SEQ)),
        "g_mix_norm": gain(ks[2], D_MODEL),
        "w_in": nrm(ks[3], (L, D_MODEL, IN_WIDTH), D_MODEL ** -0.5),
        "g_q_lat": gain(ks[4], Q_LORA),
        "w_q_up": nrm(ks[5], (L, Q_LORA, N_HEADS * (QK_NOPE + QK_ROPE)), Q_LORA ** -0.5),
        "g_kv_lat": gain(ks[6], KV_LORA),
        "w_kv_up": nrm(ks[7], (L, KV_LORA, N_HEADS * (QK_NOPE + V_HEAD)), KV_LORA ** -0.5),
        "ssm_a_re": -0.5 + 0.01 * jax.random.normal(ks[8], (L, SSM_GROUPS, SSM_STATE), jnp.float32),
        "ssm_a_im": a_im + 0.01 * jax.random.normal(ks[9], (L, SSM_GROUPS, SSM_STATE), jnp.float32),
        "ssm_b_re": nrm(ks[10], (L, SSM_GROUPS, SSM_STATE, SSM_CH), (2 * SSM_CH) ** -0.5),
        "ssm_b_im": nrm(ks[11], (L, SSM_GROUPS, SSM_STATE, SSM_CH), (2 * SSM_CH) ** -0.5),
        "ssm_c_re": nrm(ks[12], (L, SSM_GROUPS, SSM_CH, SSM_STATE), SSM_STATE ** -0.5),
        "ssm_c_im": nrm(ks[13], (L, SSM_GROUPS, SSM_CH, SSM_STATE), SSM_STATE ** -0.5),
        "ssm_d": nrm(ks[14], (L, SSM_GROUPS, SSM_CH), 1.0),
        "ssm_log_step": jax.random.uniform(ks[15], (L, SSM_GROUPS), jnp.float32,
                                           math.log(STEP_MIN), math.log(STEP_MAX)),
        "w_glu": nrm(ks[16], (L, SSM_WIDTH, SSM_WIDTH), SSM_WIDTH ** -0.5),
        "b_glu": nrm(ks[17], (L, SSM_WIDTH), 0.01),
        "g_attn_out": gain(ks[18], MLA_WIDTH),
        "g_ssm_out": gain(ks[19], SSM_WIDTH),
        "w_out": nrm(ks[20], (L, MIX_WIDTH, D_MODEL), MIX_WIDTH ** -0.5),
        "g_moe_norm": gain(ks[21], D_MODEL),
        "w_group_router": nrm(ks[22], (L, D_MODEL, N_EXPERT_GROUPS), D_MODEL ** -0.5),
        "b_group_router": nrm(ks[23], (L, N_EXPERT_GROUPS), 0.01),
        "w_expert_router": nrm(ks[24], (L, D_MODEL, N_EXPERTS), D_MODEL ** -0.5),
        "b_expert_router": nrm(ks[25], (L, N_EXPERTS), 0.01),
        "w_exp_gate": nrm(ks[26], (L, N_EXPERTS, D_MODEL, D_EXPERT), D_MODEL ** -0.5),
        "w_exp_up": nrm(ks[27], (L, N_EXPERTS, D_MODEL, D_EXPERT), D_MODEL ** -0.5),
        "w_exp_down": nrm(ks[28], (L, N_EXPERTS, D_EXPERT, D_MODEL), D_EXPERT ** -0.5),
        "g_ple_norm": gain(ks[29], D_MODEL),
        "w_ple_gate": nrm(ks[30], (L, D_MODEL, D_MODEL), D_MODEL ** -0.5),
        "w_ple_proj": nrm(ks[31], (L, PLE_DIM, D_MODEL), PLE_DIM ** -0.5),
        "g_final": 1.0 + 0.01 * jax.random.normal(ks[32], (D_MODEL,), jnp.float32),
    }


def reference(x, p, positions, g_mix_norm, w_in, g_q_lat, w_q_up, g_kv_lat, w_kv_up,
              ssm_a_re, ssm_a_im, ssm_b_re, ssm_b_im, ssm_c_re, ssm_c_im, ssm_d, ssm_log_step,
              w_glu, b_glu, g_attn_out, g_ssm_out, w_out, g_moe_norm,
              w_group_router, b_group_router, w_expert_router, b_expert_router,
              w_exp_gate, w_exp_up, w_exp_down, g_ple_norm, w_ple_gate, w_ple_proj, g_final):
    cos, sin = rope_tables(positions)
    h = x
    for i in range(DEPTH):
        z = rmsnorm(h, g_mix_norm[i]) @ w_in[i]
        attn = mla_group(z[..., :OFF_KV], z[..., OFF_KV:OFF_KR], z[..., OFF_KR:OFF_SSM], cos, sin,
                         g_q_lat[i], w_q_up[i], g_kv_lat[i], w_kv_up[i])
        ssm = s5_group(z[..., OFF_SSM:], ssm_a_re[i], ssm_a_im[i], ssm_b_re[i], ssm_b_im[i],
                       ssm_c_re[i], ssm_c_im[i], ssm_d[i], ssm_log_step[i], w_glu[i], b_glu[i])
        mix = jnp.concatenate([rmsnorm(attn, g_attn_out[i]), rmsnorm(ssm, g_ssm_out[i])], axis=-1)
        h = h + mix @ w_out[i]
        h = h + hier_moe(rmsnorm(h, g_moe_norm[i]), w_group_router[i], b_group_router[i],
                         w_expert_router[i], b_expert_router[i],
                         w_exp_gate[i], w_exp_up[i], w_exp_down[i])
        gate = jax.nn.sigmoid(rmsnorm(h, g_ple_norm[i]) @ w_ple_gate[i])
        h = h + (p[i] @ w_ple_proj[i]) * gate
    return rmsnorm(h, g_final)
```

```cpp
#include <hip/hip_runtime.h>
#include <cstdint>
#include <cstdio>

#ifndef NAIVE_GEMM
#define NAIVE_GEMM 0
#endif
#ifndef NAIVE_ATTN
#define NAIVE_ATTN 0
#endif
#ifndef PH_MASK
#define PH_MASK 127
#endif
#ifndef REP_P0
#define REP_P0 1
#endif
#ifndef REP_P1
#define REP_P1 1
#endif
#ifndef REP_P2S
#define REP_P2S 1
#endif
#ifndef REP_P2A
#define REP_P2A 1
#endif
#ifndef REP_P4
#define REP_P4 1
#endif
#ifndef USE_CG_SYNC
#define USE_CG_SYNC 0
#endif

#define LAS __attribute__((address_space(3)))
#define GAS __attribute__((address_space(1)))
typedef unsigned short bf16;
typedef short bf16x8 __attribute__((ext_vector_type(8)));
typedef float f32x4 __attribute__((ext_vector_type(4)));
typedef float f32x16 __attribute__((ext_vector_type(16)));
typedef unsigned u32x4 __attribute__((ext_vector_type(4)));
typedef unsigned u32x2 __attribute__((ext_vector_type(2)));
typedef LAS unsigned char* ldsp;

constexpr int T = 32768, DM = 1024, NB = 16, SEQ = 2048, DEPTH = 2, NH = 8;
constexpr int NTILE = T / 128;
constexpr float EPS = 1e-6f;
constexpr float QSCALE = 0.10206207261596577f * 1.4426950408889634f;

constexpr size_t KiB = 1024, MiB = 1024 * 1024;
constexpr size_t WS_CTL = 0, CTL_BYTES = 64 * KiB;
constexpr size_t WS_W = 1 * MiB, LAYER_W = 64 * MiB;
constexpr size_t OW_W1 = 0, OW_QN = 2048 * KiB  , OW_KN = 2432 * KiB, OW_VV = 2560 * KiB, OW_GLU = 2688 * KiB,
                 OW_WR = 3200 * KiB, OW_OUT = 3328 * KiB, OW_PGC = 5376 * KiB  , OW_SIN = 8192 * KiB, OW_STW = 10240 * KiB,
                 OW_GU = 16384 * KiB, OW_DN = 49152 * KiB;
constexpr size_t WS_HB = 129 * MiB;
constexpr size_t WS_R1 = 193 * MiB, WS_Q = WS_R1, WS_K = WS_R1 + 48 * MiB, WS_VT = WS_R1 + 96 * MiB, WS_YBUF = WS_R1;
constexpr size_t WS_MIX = 321 * MiB;
constexpr size_t WS_U2 = 385 * MiB, WS_YG = 417 * MiB, WS_HB2 = 385 * MiB;
constexpr size_t WS_SCR = 449 * MiB, SCR_PER_WG = 128 * KiB;
constexpr size_t WS_MISC = 481 * MiB;
constexpr size_t WS_CS = WS_MISC, WS_LIST = WS_MISC + 4 * MiB, WS_SLOTW = WS_MISC + 8 * MiB, WS_RINVM = WS_SLOTW + 256 * KiB,
                 WS_ROWSS = WS_RINVM + 128 * KiB, WS_LAM16 = WS_ROWSS + 128 * KiB, WS_S5T = WS_LAM16 + 64 * KiB, WS_ATTSS = WS_S5T + 64 * 40 * KiB, WS_END = WS_ATTSS + 8 * 128 * KiB;
static_assert(WS_END <= 512 * MiB, "ws map");
constexpr int CW_BAR = 1024;
constexpr int CW_CNT = 8192;
constexpr int CW_XL = 6144;
constexpr int LDS_B0 = 65536;
constexpr int LDS_MISC = 131072, LDS_TOTAL = LDS_MISC + 24576;
constexpr int M_F = LDS_MISC;
constexpr int M_LOG = LDS_B0;
constexpr int M_EID = LDS_MISC + 16384;
constexpr int M_RANK = M_EID + 1024;
constexpr int M_W2 = M_RANK + 1024;
constexpr int M_CNT = M_W2 + 1024;
constexpr int M_BASE = M_CNT + 128;
constexpr int M_ECNT = M_BASE + 128;
constexpr int M_TOK = M_ECNT + 128;
constexpr int M_SLOT = M_TOK + 640;
constexpr int M_WT = M_SLOT + 640;
constexpr int M_RV = M_WT + 640;
constexpr int M_BARST = M_RV + 640;
constexpr int MOE_STG = 36864, MOE_HD = 2 * MOE_STG;
static_assert(MOE_HD + 2 * MOE_STG <= M_EID, "expert-phase LDS image must end below the integer arrays");
static_assert(M_BARST + 16 <= LDS_TOTAL && LDS_TOTAL <= 163840, "lds map");

typedef float f32x2_t __attribute__((ext_vector_type(2)));
typedef __bf16 bf16x2_t __attribute__((ext_vector_type(2)));
__device__ __forceinline__ unsigned cvtpk(float lo, float hi) { f32x2_t v = {lo, hi}; bf16x2_t b = __builtin_convertvector(v, bf16x2_t); return __builtin_bit_cast(unsigned, b); }
__device__ __forceinline__ float bflo(unsigned w) { return __uint_as_float(w << 16); }
__device__ __forceinline__ float bfhi(unsigned w) { return __uint_as_float(w & 0xffff0000u); }
__device__ __forceinline__ float bf2f(bf16 b) { return __uint_as_float(((unsigned)b) << 16); }
__device__ __forceinline__ u32x2 pack4(f32x4 v) { u32x2 r; r.x = cvtpk(v[0], v[1]); r.y = cvtpk(v[2], v[3]); return r; }
__device__ __forceinline__ u32x4 pack8(f32x4 a, f32x4 b) { u32x4 r; r.x = cvtpk(a[0], a[1]); r.y = cvtpk(a[2], a[3]); r.z = cvtpk(b[0], b[1]); r.w = cvtpk(b[2], b[3]); return r; }
__device__ __forceinline__ f32x4 unpack4(u32x2 w) { f32x4 r; r[0] = bflo(w.x); r[1] = bfhi(w.x); r[2] = bflo(w.y); r[3] = bfhi(w.y); return r; }
__device__ __forceinline__ float sigmoidf_(float x) { return __builtin_amdgcn_rcpf(1.0f + __builtin_amdgcn_exp2f(-1.4426950408889634f * x)); }
__device__ __forceinline__ float gelu_tanh(float x) { const float u = 0.7978845608028654f * (x + 0.044715f * x * x * x);
    return x * __builtin_amdgcn_rcpf(1.0f + __builtin_amdgcn_exp2f(-2.8853900817779268f * u)); }
#define VM_WAIT() asm volatile("s_waitcnt vmcnt(0)" ::: "memory")
#define BLOCK_SEAM() do { VM_WAIT(); __syncthreads(); } while (0)

#define XB_TMO      128
#define XB_XCNT(j)  (256  + 64 * (j))
#define XB_XSUB(j)  (1280 + 64 * (j))
#define XB_XGEN(j)  (2304 + 64 * (j))
#define XB_TOP      3328
#define XB_TOPGEN   3392
#define XCD_BAR_WORDS 3456
#define XB_SPIN_CAP (1u << 20)
__device__ __forceinline__ unsigned xb_ld(unsigned* p)              { return __hip_atomic_load(p, __ATOMIC_RELAXED, __HIP_MEMORY_SCOPE_AGENT); }
__device__ __forceinline__ unsigned xb_add(unsigned* p, unsigned v) { return __hip_atomic_fetch_add(p, v, __ATOMIC_RELAXED, __HIP_MEMORY_SCOPE_AGENT); }
__device__ __forceinline__ unsigned xb_xcc_id() { return (unsigned)__builtin_amdgcn_s_getreg((3 << 11) | 20) & 0xFu; }
#define XB_SPIN(cond, bar) do { unsigned _sp = 0; while (cond) { __builtin_amdgcn_s_sleep(1); \
    if ((++_sp & 255u) == 0u) { if (xb_ld(&(bar)[XB_TMO])) break; if (_sp > XB_SPIN_CAP) { atomicAdd(&(bar)[XB_TMO], 1u); break; } } } } while (0)
struct XcdBarrier { unsigned* bar; unsigned x; volatile LAS unsigned* st; };
__device__ __forceinline__ XcdBarrier xcd_barrier_post(unsigned* bar, volatile LAS unsigned* st) {
    XcdBarrier b; b.bar = bar; b.x = xb_xcc_id(); b.st = st;
    if (threadIdx.x == 0) (void)xb_add(&bar[XB_XCNT(b.x)], 1u);
    return b;
}
__device__ __forceinline__ void xcd_barrier_complete(unsigned* bar, unsigned x, unsigned& nloc, unsigned& nx) {
    const unsigned G = gridDim.x * gridDim.y * gridDim.z;
    unsigned sum, cnt, mine, sp = 0u;
    for (;;) {
        sum = 0u; cnt = 0u; mine = 0u;
#pragma unroll
        for (unsigned j = 0; j < 16; ++j) { const unsigned c = xb_ld(&bar[XB_XCNT(j)]); sum += c; cnt += (c > 0u) ? 1u : 0u; mine = (j == x) ? c : mine; }
        if (sum == G) break;
        __builtin_amdgcn_s_sleep(1);
        if ((++sp & 255u) == 0u) { if (xb_ld(&bar[XB_TMO])) break; if (sp > XB_SPIN_CAP) { atomicAdd(&bar[XB_TMO], 1u); break; } }
    }
    nloc = mine > 0u ? mine : 1u; nx = cnt > 0u ? cnt : 1u;
}
__device__ __forceinline__ void xcd_barrier(const XcdBarrier& b) {
    asm volatile("s_waitcnt vmcnt(0)" ::: "memory");
    __syncthreads();
    if (threadIdx.x == 0) {
        unsigned* bar = b.bar;
        __builtin_amdgcn_s_waitcnt(0);
        unsigned nloc = b.st[0], nx = b.st[1];
        if (nloc == 0u) { xcd_barrier_complete(bar, b.x, nloc, nx); b.st[0] = nloc; b.st[1] = nx; }
        const unsigned old = xb_add(&bar[XB_XSUB(b.x)], 1u);
        const unsigned gen = old / nloc;
        if (old + 1u == (gen + 1u) * nloc) {
            __builtin_amdgcn_fence(__ATOMIC_RELEASE, "agent");
            asm volatile("s_waitcnt vmcnt(0)" ::: "memory");
            const unsigned og = xb_add(&bar[XB_TOP], 1u);
            const unsigned tg = og / nx;
            if (og + 1u == (tg + 1u) * nx) xb_add(&bar[XB_TOPGEN], 1u);
            else XB_SPIN(xb_ld(&bar[XB_TOPGEN]) == tg, bar);
            __builtin_amdgcn_fence(__ATOMIC_ACQUIRE, "agent");
            xb_add(&bar[XB_XGEN(b.x)], 1u);
            asm volatile("s_waitcnt vmcnt(0)" ::: "memory");
        } else {
            XB_SPIN(xb_ld(&bar[XB_XGEN(b.x)]) == gen, bar);
            __builtin_amdgcn_fence(__ATOMIC_ACQUIRE, "agent");
            asm volatile("s_waitcnt vmcnt(0)" ::: "memory");
        }
    }
    __syncthreads();
}

struct ALPlain { const bf16* p; int ld; __device__ __forceinline__ const bf16* ptr(int row, int k) const { return p + (size_t)row * ld + k; }
    __device__ __forceinline__ u32x4 load(int row, int k) const { return *(const u32x4*)ptr(row, k); } };
struct ALTwo { const bf16* p0; int ld0; int k0; const bf16* p1; int ld1;
    __device__ __forceinline__ const bf16* ptr(int row, int k) const { return (k < k0) ? p0 + (size_t)row * ld0 + k : p1 + (size_t)row * ld1 + (k - k0); }
    __device__ __forceinline__ u32x4 load(int row, int k) const { return *(const u32x4*)ptr(row, k); } };
struct ALF32Two { const float* p0; int ld0; int k0; const bf16* p1; int ld1;
    __device__ __forceinline__ u32x4 load(int row, int k) const {
        if (k < k0) { const f32x4 a = *(const f32x4*)(p0 + (size_t)row * ld0 + k), b = *(const f32x4*)(p0 + (size_t)row * ld0 + k + 4); return pack8(a, b); }
        return *(const u32x4*)(p1 + (size_t)row * ld1 + (k - k0)); } };
struct ALGather { const bf16* p; int ld; const LAS int* rows;
    __device__ __forceinline__ const bf16* ptr(int row, int k) const { return p + (size_t)rows[row] * ld + k; }
    __device__ __forceinline__ u32x4 load(int row, int k) const { return *(const u32x4*)ptr(row, k); } };


__device__ __forceinline__ float dot8(u32x4 a, u32x4 b) {
    return bflo(a.x) * bflo(b.x) + bfhi(a.x) * bfhi(b.x) + bflo(a.y) * bflo(b.y) + bfhi(a.y) * bfhi(b.y) + bflo(a.z) * bflo(b.z) + bfhi(a.z) * bfhi(b.z) + bflo(a.w) * bflo(b.w) + bfhi(a.w) * bfhi(b.w);
}
__device__ __forceinline__ size_t fm_off(int n, int k, int K) { return ((size_t)((n >> 4) * (K >> 5) + (k >> 5)) << 9) + (size_t)(((((k & 31) >> 3) << 4) + (n & 15)) << 3) + (k & 7); }

__device__ __forceinline__ size_t fm_off_p(int n, int k, int K) { const int sl = n & 31; return fm_off((n & ~31) + ((sl >> 2) & 1) * 16 + 4 * (sl >> 3) + (sl & 3), k, K); }
struct NoHook { template <class T> __device__ __forceinline__ void operator()(T&, int, int, int) const {} };
template <int NFW, bool SWAP, bool MHALF = false, bool ARES = false, bool SKIPI = false, class AL, class Epi, class Hook = NoHook>
__device__ __forceinline__ void gemm_rows(ldsp lds, const AL& A, const bf16* __restrict__ Bfm, int K, int NT, int nactive, const Epi& epi, bool full = true, bool rotk = true, int khook = -1, const Hook& hook = NoHook()) {
    int tid = threadIdx.x; asm volatile("" : "+v"(tid));
    const int lane = tid & 63, w = __builtin_amdgcn_readfirstlane(tid >> 6), l15 = lane & 15, q = lane >> 4;
    const bool act = w < nactive;
    const int wc = act ? w : nactive - 1;
    f32x4 acc[8][NFW];
#pragma unroll
    for (int m = 0; m < 8; ++m)
#pragma unroll
        for (int n = 0; n < NFW; ++n) acc[m][n] = (f32x4){0.f, 0.f, 0.f, 0.f};
    const int nk = K >> 7, KB = K >> 5, total = NT * nk;
    u32x4 ra[2][4], rb[2][NFW][4];
    const int ar0 = tid >> 4, ac = (tid & 15) * 8;
    const int aw0 = ar0 * 256 + (((tid & 15) ^ (ar0 & 15)) << 4);
    const bf16* bw = Bfm + (size_t)wc * NFW * KB * 512 + lane * 8;
    const int rot1 = (int)(blockIdx.x >> 3) % NT, rot2 = rotk ? (int)(blockIdx.x >> 5) % nk : 0;
    int nti = 0, kti = 0, ktia = 0;
#define G_ADDR_A() int ktra_ = ktia + rot2; if (ktra_ >= nk) ktra_ -= nk; const int k0_ = ktra_ * 128 + ac; if (++ktia == nk) ktia = 0;
#define G_ADDR_B() int ntr_ = nti + rot1; if (ntr_ >= NT) ntr_ -= NT; int ktr_ = kti + rot2; if (ktr_ >= nk) ktr_ -= nk; \
        const bf16* bp_ = bw + ((size_t)ntr_ * 8 * NFW * KB + ktr_ * 4) * 512; \
        if (kti + 1 < nk) ++kti; else if (nti + 1 < NT) { kti = 0; ++nti; }
#define G_LA(st, i_) do { if (!ARES) ra[st][i_] = A.load(ar0 + 32 * (i_), k0_); } while (0)
#define G_SA(st, stg, i_) do { if (!ARES) *(LAS u32x4*)(lds + (stg) * 32768 + aw0 + (i_) * 8192) = ra[st][i_]; } while (0)
#define G_LB(sb, j_) do { if ((j_) < NFW * 4) { if (!SKIPI || act) rb[sb][(j_) >> 2][(j_) & 3] = *(const u32x4*)(bp_ + ((size_t)((j_) >> 2) * KB + ((j_) & 3)) * 512); } } while (0)
#define G_PIECE(sa_, g_) do { if ((g_) == 0) { G_LA(sa_, 0); G_LA(sa_, 1); } else if ((g_) == 1) { G_LA(sa_, 2); G_LA(sa_, 3); } \
        else if ((g_) == 2) { G_LB(1 - (sa_), 0); if (NFW == 2) G_LB(1 - (sa_), 4); G_SA(1 - (sa_), 1 - (sa_), 0); } \
        else if ((g_) == 3) { G_LB(1 - (sa_), 1); G_SA(1 - (sa_), 1 - (sa_), 1); } else if ((g_) == 4) { G_LB(1 - (sa_), 2); if (NFW == 2) G_LB(1 - (sa_), 5); G_SA(1 - (sa_), 1 - (sa_), 2); } \
        else if ((g_) == 5) { G_LB(1 - (sa_), 3); G_SA(1 - (sa_), 1 - (sa_), 3); } else if ((g_) == 6) { if (NFW == 2) G_LB(1 - (sa_), 6); } else { if (NFW == 2) G_LB(1 - (sa_), 7); } } while (0)
    int nt = 0, kt = 0;
#define G_STEP(sa) { G_ADDR_A(); G_ADDR_B(); \
        if (SKIPI && !act) { G_LA(sa, 0); G_LA(sa, 1); G_LA(sa, 2); G_LA(sa, 3); G_SA(1 - (sa), 1 - (sa), 0); G_SA(1 - (sa), 1 - (sa), 1); G_SA(1 - (sa), 1 - (sa), 2); G_SA(1 - (sa), 1 - (sa), 3); } else \
        { const ldsp a_ = (ARES ? lds + LDS_B0 + kt * 32768 : lds + (sa) * 32768) + l15 * 256; bf16x8 af[2][4]; \
            _Pragma("unroll") for (int m = 0; m < 4; ++m) af[0][m] = *(const LAS bf16x8*)(a_ + m * 4096 + ((q ^ l15) << 4)); \
            _Pragma("unroll") for (int g = 0; g < 8; ++g) { const int ks = g >> 1, mh = (g & 1) * 4; \
                if (g < 7) { const int ks1 = (g + 1) >> 1, mh1 = ((g + 1) & 1) * 4; \
                    if (!MHALF || mh1 == 0 || full) { _Pragma("unroll") for (int m = 0; m < 4; ++m) af[(g + 1) & 1][m] = *(const LAS bf16x8*)(a_ + (mh1 + m) * 4096 + (((ks1 * 4 + q) ^ l15) << 4)); } } \
                __builtin_amdgcn_sched_barrier(0); \
                G_PIECE(sa, g); __builtin_amdgcn_sched_barrier(0); \
                if (!MHALF || mh == 0 || full) { \
                _Pragma("unroll") for (int m = 0; m < 4; ++m) _Pragma("unroll") for (int n = 0; n < NFW; ++n) \
                    acc[mh + m][n] = SWAP ? __builtin_amdgcn_mfma_f32_16x16x32_bf16(__builtin_bit_cast(bf16x8, rb[sa][n][ks]), af[g & 1][m], acc[mh + m][n], 0, 0, 0) \
                                          : __builtin_amdgcn_mfma_f32_16x16x32_bf16(af[g & 1][m], __builtin_bit_cast(bf16x8, rb[sa][n][ks]), acc[mh + m][n], 0, 0, 0); } \
                __builtin_amdgcn_sched_barrier(0); } } \
        if (kt == khook) { if (act) { int l15h = l15, qh = q; asm volatile("" : "+v"(l15h), "+v"(qh)); hook(acc, w, l15h, qh); } } \
        if (++kt == nk) { kt = 0; \
            if (act) { int l15e = l15, qe = q; asm volatile("" : "+v"(l15e), "+v"(qe)); epi((nt + rot1 >= NT) ? nt + rot1 - NT : nt + rot1, acc, w, l15e, qe); } \
            _Pragma("unroll") for (int m = 0; m < 8; ++m) _Pragma("unroll") for (int n = 0; n < NFW; ++n) acc[m][n] = (f32x4){0.f, 0.f, 0.f, 0.f}; \
            ++nt; } \
        __syncthreads(); }
    {
        { G_ADDR_A(); G_LA(0, 0); G_LA(0, 1); G_LA(0, 2); G_LA(0, 3); }
        { G_ADDR_A(); G_LA(1, 0); G_LA(1, 1); G_LA(1, 2); G_LA(1, 3); }
        { G_ADDR_B(); G_LB(0, 0); G_LB(0, 1); G_LB(0, 2); G_LB(0, 3); G_LB(0, 4); G_LB(0, 5); G_LB(0, 6); G_LB(0, 7); }
        G_SA(0, 0, 0); G_SA(0, 0, 1); G_SA(0, 0, 2); G_SA(0, 0, 3);
        __syncthreads();
    }
    int s = 0;
    for (; s + 1 < total; s += 2) { G_STEP(0) G_STEP(1) }
    if (s < total) G_STEP(0)
#undef G_ADDR_A
#undef G_ADDR_B
#undef G_LA
#undef G_SA
#undef G_LB
#undef G_PIECE
#undef G_STEP
}

template <bool ARES, class AL, class Epi>
__device__ __forceinline__ void gemm_moe(ldsp lds, const AL& A, const bf16* __restrict__ Bfm, int K, int NT, int nmf, const Epi& epi) {
    int tid = threadIdx.x; asm volatile("" : "+v"(tid));
    const int lane = tid & 63, w = __builtin_amdgcn_readfirstlane(tid >> 6), l15 = lane & 15, q = lane >> 4;
    f32x4 acc[9][2];
#pragma unroll
    for (int m = 0; m < 9; ++m) { acc[m][0] = (f32x4){0.f, 0.f, 0.f, 0.f}; acc[m][1] = (f32x4){0.f, 0.f, 0.f, 0.f}; }
    const int nk = K >> 7, KB = K >> 5, total = NT * nk;
    u32x4 ra[2][5], rb[2][2][4];
    const int ar0 = tid >> 4, ac = (tid & 15) * 8;
    const int aw0 = ar0 * 256 + (((tid & 15) ^ (ar0 & 15)) << 4);
    const bool a4 = tid < 256;
    const bf16* bw = Bfm + (size_t)w * 2 * KB * 512 + lane * 8;
    int nti = 0, kti = 0, ktia = 0;
#define M_ADDR_A() const int k0_ = ktia * 128 + ac; if (++ktia == nk) ktia = 0;
#define M_ADDR_B() const bf16* bp_ = bw + ((size_t)nti * 16 * KB + kti * 4) * 512; if (kti + 1 < nk) ++kti; else if (nti + 1 < NT) { kti = 0; ++nti; }
#define M_LA(st, i_) do { if (!ARES) { if ((i_) < 4 || a4) ra[st][i_] = A.load(ar0 + 32 * (i_), k0_); } } while (0)
#define M_SA(st, stg, i_) do { if (!ARES) { if ((i_) < 4 || a4) *(LAS u32x4*)(lds + (stg) * MOE_STG + aw0 + (i_) * 8192) = ra[st][i_]; } } while (0)
#define M_LB(sb, j_) do { rb[sb][(j_) >> 2][(j_) & 3] = *(const u32x4*)(bp_ + ((size_t)((j_) >> 2) * KB + ((j_) & 3)) * 512); } while (0)
#define M_PIECE(sa_, g_) do { if ((g_) == 0) { M_LA(sa_, 0); M_LA(sa_, 1); } else if ((g_) == 1) { M_LA(sa_, 2); M_LA(sa_, 3); } else if ((g_) == 2) { M_LA(sa_, 4); } \
        else if ((g_) == 3) { M_LB(1 - (sa_), 0); M_LB(1 - (sa_), 4); } else if ((g_) == 4) { M_LB(1 - (sa_), 1); M_SA(1 - (sa_), 1 - (sa_), 0); } else if ((g_) == 5) { M_LB(1 - (sa_), 2); M_SA(1 - (sa_), 1 - (sa_), 1); } \
        else if ((g_) == 6) { M_LB(1 - (sa_), 5); M_SA(1 - (sa_), 1 - (sa_), 2); } else if ((g_) == 7) { M_LB(1 - (sa_), 3); M_SA(1 - (sa_), 1 - (sa_), 3); } else if ((g_) == 8) { M_LB(1 - (sa_), 6); M_SA(1 - (sa_), 1 - (sa_), 4); } \
        else if ((g_) == 9) { M_LB(1 - (sa_), 7); } } while (0)
    int nt = 0, kt = 0;
#define M_STEP(sa) { M_ADDR_A(); M_ADDR_B(); \
        { const ldsp a_ = (ARES ? lds + MOE_HD + kt * MOE_STG : lds + (sa) * MOE_STG) + l15 * 256; bf16x8 af[2][3]; \
            _Pragma("unroll") for (int m = 0; m < 3; ++m) af[0][m] = *(const LAS bf16x8*)(a_ + m * 4096 + ((q ^ l15) << 4)); \
            _Pragma("unroll") for (int g = 0; g < 12; ++g) { const int ks = g / 3, mb = (g % 3) * 3; \
                if (g < 11) { const int ks1 = (g + 1) / 3, mb1 = ((g + 1) % 3) * 3; \
                    if (mb1 < nmf) { _Pragma("unroll") for (int m = 0; m < 3; ++m) af[(g + 1) & 1][m] = *(const LAS bf16x8*)(a_ + (mb1 + m) * 4096 + (((ks1 * 4 + q) ^ l15) << 4)); } } \
                __builtin_amdgcn_sched_barrier(0); \
                M_PIECE(sa, g); __builtin_amdgcn_sched_barrier(0); \
                if (mb < nmf) { \
                _Pragma("unroll") for (int m = 0; m < 3; ++m) _Pragma("unroll") for (int n = 0; n < 2; ++n) \
                    acc[mb + m][n] = __builtin_amdgcn_mfma_f32_16x16x32_bf16(__builtin_bit_cast(bf16x8, rb[sa][n][ks]), af[g & 1][m], acc[mb + m][n], 0, 0, 0); } \
                __builtin_amdgcn_sched_barrier(0); } } \
        if (++kt == nk) { kt = 0; \
            { int l15e = l15, qe = q; asm volatile("" : "+v"(l15e), "+v"(qe)); epi(nt, acc, w, l15e, qe); } \
            _Pragma("unroll") for (int m = 0; m < 9; ++m) { acc[m][0] = (f32x4){0.f, 0.f, 0.f, 0.f}; acc[m][1] = (f32x4){0.f, 0.f, 0.f, 0.f}; } \
            ++nt; } \
        __syncthreads(); }
    {
        { M_ADDR_A(); M_LA(0, 0); M_LA(0, 1); M_LA(0, 2); M_LA(0, 3); M_LA(0, 4); }
        { M_ADDR_A(); M_LA(1, 0); M_LA(1, 1); M_LA(1, 2); M_LA(1, 3); M_LA(1, 4); }
        { M_ADDR_B(); M_LB(0, 0); M_LB(0, 1); M_LB(0, 2); M_LB(0, 3); M_LB(0, 4); M_LB(0, 5); M_LB(0, 6); M_LB(0, 7); }
        M_SA(0, 0, 0); M_SA(0, 0, 1); M_SA(0, 0, 2); M_SA(0, 0, 3); M_SA(0, 0, 4);
        __syncthreads();
    }
    int s = 0;
    for (; s + 1 < total; s += 2) { M_STEP(0) M_STEP(1) }
    if (s < total) M_STEP(0)
#undef M_ADDR_A
#undef M_ADDR_B
#undef M_LA
#undef M_SA
#undef M_LB
#undef M_PIECE
#undef M_STEP
}

struct Params { const void* in[34]; float* out; unsigned char* ws; };
enum { I_X = 0, I_P, I_POS, I_GMIX, I_WIN, I_GQ, I_WQUP, I_GKV, I_WKVUP, I_ARE, I_AIM, I_BRE, I_BIM, I_CRE, I_CIM, I_SD, I_LOGSTEP, I_WGLU, I_BGLU,
       I_GATT, I_GSSM, I_WOUT, I_GMOE, I_WGR, I_BGR, I_WER, I_BER, I_WEG, I_WEU, I_WED, I_GPLE, I_WPG, I_WPP, I_GFIN };

struct KoffId { __device__ __forceinline__ int operator()(int, int k0) const { return k0; } };
struct PermAll { __device__ __forceinline__ bool operator()(int) const { return true; } };
struct PermNone { __device__ __forceinline__ bool operator()(int) const { return false; } };
template <class ColPtr, class LdF, class Scale, class Perm, class Koff = KoffId>
__device__ __forceinline__ void cvt_T(ldsp lds, int K, int Nout, bf16* out, ColPtr colptr, LdF ldf, Scale scale, Perm permf, int gwave, int nwaves, int lane, int wid, int rot = 0, Koff koff = KoffId()) {
    const ldsp t = lds + wid * 8704;
    const int ktiles = K >> 6, ntiles = Nout >> 6;
    int g0 = gwave - rot; if (g0 < 0) g0 += nwaves;
    for (int tl = g0; tl < ntiles * ktiles; tl += nwaves) {
        const int nt_ = tl % ntiles, k0 = (tl / ntiles) * 64;
        const float* src = colptr(nt_ * 64 + lane, k0); size_t ld = (size_t)ldf(nt_ * 64 + lane, k0);
        const float zm = src ? 1.f : 0.f;
        if (!src) { src = colptr(0, 0); ld = 0; }
        src += (size_t)koff(nt_ * 64 + lane, k0) * ld;
        float vv[64];
#pragma unroll
        for (int kk = 0; kk < 64; ++kk) vv[kk] = src[(size_t)kk * ld];
#pragma unroll
        for (int kk = 0; kk < 64; kk += 2)
            *(LAS unsigned*)(t + lane * 136 + kk * 2) = cvtpk(vv[kk] * (scale(k0 + kk) * zm), vv[kk + 1] * (scale(k0 + kk + 1) * zm));
#pragma unroll
        for (int i = 0; i < 8; ++i) { const int nbl = i >> 1, pp = lane & 15, c = (i & 1) * 4 + (lane >> 4);
            const int row = permf(nt_ * 2 + (nbl >> 1)) ? (nbl >> 1) * 32 + 8 * (pp >> 2) + 4 * (nbl & 1) + (pp & 3) : nbl * 16 + pp;
            const u32x2 a = *(const LAS u32x2*)(t + row * 136 + c * 16), b = *(const LAS u32x2*)(t + row * 136 + c * 16 + 8);
            *(u32x4*)(out + (((size_t)(nt_ * 4 + (i >> 1)) * (K >> 5) + (k0 >> 5) + (i & 1)) << 9) + lane * 8) = (u32x4){a.x, a.y, b.x, b.y}; }
    }
}

constexpr int AT_KP = 208, AT_VP = 136;
constexpr int AT_K0 = 0, AT_V0 = 26624;
__device__ __forceinline__ int crow(int r, int hi) { return (r & 3) + 8 * (r >> 2) + 4 * hi; }
__device__ __forceinline__ float max3f(float a, float b, float c) { float r; asm("v_max3_f32 %0, %1, %2, %3" : "=v"(r) : "v"(a), "v"(b), "v"(c)); return r; }

__device__ __forceinline__ void attn_unit(ldsp lds, int b, int h, int qb, const bf16* __restrict__ Q, const bf16* __restrict__ Kg, const bf16* __restrict__ Vt, bf16* MIX, float* ATTSS) {
    int tid = threadIdx.x; asm volatile("" : "+v"(tid));
    const int lane = tid & 63, wid = __builtin_amdgcn_readfirstlane(tid >> 6), r32 = lane & 31, hh = lane >> 5;
    const size_t bh = (size_t)b * NH + h;
    const bf16* Qb = Q + bh * SEQ * 96;
    const bf16* Kb = Kg + bh * SEQ * 96;
    const bf16* Vb = Vt + bh * 64 * SEQ;
#if NAIVE_ATTN
    if (tid < 256) {
        const int qi = qb * 256 + tid;
        float qv[96];
#pragma unroll
        for (int d = 0; d < 96; ++d) qv[d] = bf2f(Qb[(size_t)qi * 96 + d]);
        float m = -1e30f, l = 0.f, o[64];
#pragma unroll
        for (int d = 0; d < 64; ++d) o[d] = 0.f;
        for (int kv = 0; kv <= qi; ++kv) {
            float s = 0.f;
#pragma unroll
            for (int d = 0; d < 96; ++d) s += qv[d] * bf2f(Kb[(size_t)kv * 96 + d]);
            const float mn = fmaxf(m, s), al = exp2f(m - mn), p = exp2f(s - mn);
            l = l * al + p; m = mn;
#pragma unroll
            for (int d = 0; d < 64; ++d) o[d] = o[d] * al + p * bf2f(Vb[(size_t)d * SEQ + kv]);
        }
        const float inv = 1.f / l;
        bf16* dst = MIX + ((size_t)b * SEQ + qi) * 1024 + h * 64;
#pragma unroll
        float ssq = 0.f;
#pragma unroll
        for (int d = 0; d < 64; d += 2) { const unsigned wv = cvtpk(o[d] * inv, o[d + 1] * inv); *(unsigned*)(dst + d) = wv; ssq += bflo(wv) * bflo(wv) + bfhi(wv) * bfhi(wv); }
        ATTSS[(size_t)h * T + (size_t)b * SEQ + qi] = ssq;
    }
    __syncthreads();
#else
    const int qrow = qb * 256 + wid * 32 + r32;
    bf16x8 qf[6];
#pragma unroll
    for (int s = 0; s < 6; ++s) qf[s] = *(const bf16x8*)(Qb + (size_t)qrow * 96 + 16 * s + 8 * hh);
    const int nt = 4 * (qb + 1);
    f32x16 o0, o1;
#pragma unroll
    for (int r = 0; r < 16; ++r) { o0[r] = 0.f; o1[r] = 0.f; }
    float m = 0.f, l = 0.f;
    f32x16 negm;
#pragma unroll
    for (int r = 0; r < 16; ++r) negm[r] = 0.f;
    u32x4 kr0, kr1, vr;
    const int k0row = tid / 12, k0c = tid % 12, k1row = (tid + 512) / 12, k1c = (tid + 512) % 12;
    const int vd = tid >> 3, vc = tid & 7;
#define AT_LOAD(t) do { const bf16* kt_ = Kb + (size_t)(t) * 64 * 96; kr0 = *(const u32x4*)(kt_ + k0row * 96 + k0c * 8); if (tid < 256) kr1 = *(const u32x4*)(kt_ + k1row * 96 + k1c * 8); \
        vr = *(const u32x4*)(Vb + (size_t)vd * SEQ + (t) * 64 + vc * 8); } while (0)
#define AT_STORE(kst, vst) do { const ldsp kb_ = lds + AT_K0 + (kst) * 13312, vb_ = lds + AT_V0 + (vst) * 8704; *(LAS u32x4*)(kb_ + k0row * AT_KP + k0c * 16) = kr0; \
        if (tid < 256) *(LAS u32x4*)(kb_ + k1row * AT_KP + k1c * 16) = kr1; \
        *(LAS u32x2*)(vb_ + vd * AT_VP + vc * 16) = (u32x2){vr.x, vr.y}; *(LAS u32x2*)(vb_ + vd * AT_VP + vc * 16 + 8) = (u32x2){vr.z, vr.w}; } while (0)
#define AT_PV(vs_) do { const ldsp vb = lds + AT_V0 + (vs_) * 8704 + r32 * AT_VP + hh * 8; \
        _Pragma("unroll") for (int s = 0; s < 4; ++s) { \
            const u32x2 a0 = *(const LAS u32x2*)(vb + s * 32), a1 = *(const LAS u32x2*)(vb + s * 32 + 16); \
            const u32x2 c0 = *(const LAS u32x2*)(vb + 32 * AT_VP + s * 32), c1 = *(const LAS u32x2*)(vb + 32 * AT_VP + s * 32 + 16); \
            const u32x4 v0 = (u32x4){a0.x, a0.y, a1.x, a1.y}, v1 = (u32x4){c0.x, c0.y, c1.x, c1.y}; \
            o0 = __builtin_amdgcn_mfma_f32_32x32x16_bf16(__builtin_bit_cast(bf16x8, v0), __builtin_bit_cast(bf16x8, pk[s]), o0, 0, 0, 0); \
            o1 = __builtin_amdgcn_mfma_f32_32x32x16_bf16(__builtin_bit_cast(bf16x8, v1), __builtin_bit_cast(bf16x8, pk[s]), o1, 0, 0, 0); } } while (0)
    const bool lag = wid >= 4;
    bool havepk = false;
    u32x4 pk[4];
    AT_LOAD(0); AT_STORE(0, 0); __syncthreads();
    int vs = 0, vsp = 2;
    for (int t = 0; t < nt; ++t) {
        const bool more = (t + 1 < nt);
        if (more) AT_LOAD(t + 1);
        if (lag && havepk) { AT_PV(vsp); havepk = false; }
        if (t * 64 <= qb * 256 + wid * 32 + 31) {
        const ldsp kb = lds + AT_K0 + (t & 1) * 13312 + r32 * AT_KP + hh * 16;
        f32x16 s0, s1;
        {
            const bf16x8 k0f = *(const LAS bf16x8*)(kb), k1f = *(const LAS bf16x8*)(kb + 32 * AT_KP);
            s0 = __builtin_amdgcn_mfma_f32_32x32x16_bf16(k0f, qf[0], negm, 0, 0, 0);
            s1 = __builtin_amdgcn_mfma_f32_32x32x16_bf16(k1f, qf[0], negm, 0, 0, 0);
        }
#pragma unroll
        for (int s = 1; s < 6; ++s) {
            const bf16x8 k0f = *(const LAS bf16x8*)(kb + s * 32), k1f = *(const LAS bf16x8*)(kb + 32 * AT_KP + s * 32);
            s0 = __builtin_amdgcn_mfma_f32_32x32x16_bf16(k0f, qf[s], s0, 0, 0, 0);
            s1 = __builtin_amdgcn_mfma_f32_32x32x16_bf16(k1f, qf[s], s1, 0, 0, 0);
        }
        if (t >= nt - 4) {
            const int kv0 = t * 64;
#pragma unroll
            for (int r = 0; r < 16; ++r) { const int kv = kv0 + crow(r, hh); if (kv > qrow) s0[r] = -3.0e38f; if (kv + 32 > qrow) s1[r] = -3.0e38f; }
        }
        float mxa = max3f(s0[0], s0[1], s0[2]), mxb = max3f(s1[0], s1[1], s1[2]);
        mxa = max3f(mxa, s0[3], s0[4]); mxb = max3f(mxb, s1[3], s1[4]); mxa = max3f(mxa, s0[5], s0[6]); mxb = max3f(mxb, s1[5], s1[6]);
        mxa = max3f(mxa, s0[7], s0[8]); mxb = max3f(mxb, s1[7], s1[8]); mxa = max3f(mxa, s0[9], s0[10]); mxb = max3f(mxb, s1[9], s1[10]);
        mxa = max3f(mxa, s0[11], s0[12]); mxb = max3f(mxb, s1[11], s1[12]); mxa = max3f(mxa, s0[13], s0[14]); mxb = max3f(mxb, s1[13], s1[14]);
        float mx = max3f(mxa, mxb, fmaxf(s0[15], s1[15]));
        mx = fmaxf(mx, __shfl_xor(mx, 32));
        if (t == 0 || __any(mx > 8.0f)) {
            const float d = (t == 0) ? mx : fmaxf(mx, 0.f), al = __builtin_amdgcn_exp2f(-d);
            m += d; l *= al;
#pragma unroll
            for (int r = 0; r < 16; ++r) { o0[r] *= al; o1[r] *= al; s0[r] -= d; s1[r] -= d; negm[r] = -m; }
        }
        float ls = 0.f;
#pragma unroll
        for (int r = 0; r < 16; ++r) { s0[r] = __builtin_amdgcn_exp2f(s0[r]); s1[r] = __builtin_amdgcn_exp2f(s1[r]); ls += s0[r] + s1[r]; }
        l += ls;
        pk[0] = (u32x4){cvtpk(s0[0], s0[1]), cvtpk(s0[2], s0[3]), cvtpk(s0[4], s0[5]), cvtpk(s0[6], s0[7])};
        pk[1] = (u32x4){cvtpk(s0[8], s0[9]), cvtpk(s0[10], s0[11]), cvtpk(s0[12], s0[13]), cvtpk(s0[14], s0[15])};
        pk[2] = (u32x4){cvtpk(s1[0], s1[1]), cvtpk(s1[2], s1[3]), cvtpk(s1[4], s1[5]), cvtpk(s1[6], s1[7])};
        pk[3] = (u32x4){cvtpk(s1[8], s1[9]), cvtpk(s1[10], s1[11]), cvtpk(s1[12], s1[13]), cvtpk(s1[14], s1[15])};
        havepk = true;
        if (!lag) { AT_PV(vs); havepk = false; }
        }
        vsp = vs; vs = (vs == 2) ? 0 : vs + 1;
        if (more) AT_STORE((t + 1) & 1, vs);
        __syncthreads();
    }
    if (havepk) AT_PV(vsp);
#undef AT_LOAD
#undef AT_STORE
#undef AT_PV
    l += __shfl_xor(l, 32);
    const float inv = 1.f / l;
    bf16* dst = MIX + ((size_t)b * SEQ + qrow) * 1024 + h * 64 + 4 * hh;
    float ssq = 0.f;
#pragma unroll
    for (int g4 = 0; g4 < 4; ++g4) {
        const u32x2 w0 = (u32x2){cvtpk(o0[4 * g4] * inv, o0[4 * g4 + 1] * inv), cvtpk(o0[4 * g4 + 2] * inv, o0[4 * g4 + 3] * inv)};
        const u32x2 w1 = (u32x2){cvtpk(o1[4 * g4] * inv, o1[4 * g4 + 1] * inv), cvtpk(o1[4 * g4 + 2] * inv, o1[4 * g4 + 3] * inv)};
        *(u32x2*)(dst + 8 * g4) = w0; *(u32x2*)(dst + 32 + 8 * g4) = w1;
        ssq += bflo(w0.x) * bflo(w0.x) + bfhi(w0.x) * bfhi(w0.x) + bflo(w0.y) * bflo(w0.y) + bfhi(w0.y) * bfhi(w0.y) + bflo(w1.x) * bflo(w1.x) + bfhi(w1.x) * bfhi(w1.x) + bflo(w1.y) * bflo(w1.y) + bfhi(w1.y) * bfhi(w1.y);
    }
    ssq += __shfl_xor(ssq, 32);
    if (hh == 0) ATTSS[(size_t)h * T + (size_t)b * SEQ + qrow] = ssq;
    __syncthreads();
#endif
}

__global__ void __launch_bounds__(512, 2) mk_fwd(Params P) {
    extern __shared__ __attribute__((aligned(16))) unsigned char lds_raw[];
    const ldsp lds = (ldsp)lds_raw;
    const int G = gridDim.x, wg = blockIdx.x;
    const int vwg = (G % 8 == 0) ? (wg & 7) * (G >> 3) + (wg >> 3) : wg;
#define PHASE_IDS() int tid = threadIdx.x; asm volatile("" : "+v"(tid)); const int lane = tid & 63, wid = __builtin_amdgcn_readfirstlane(tid >> 6); (void)lane; (void)wid
    unsigned char* ws = P.ws;
    unsigned* ctl = (unsigned*)(ws + WS_CTL);
    LAS float* const sF = (LAS float*)(lds + M_F);
#define SF(i) (sF + 128 * (i))
    if (threadIdx.x < 2) ((LAS unsigned*)(lds + M_BARST))[threadIdx.x] = 0u;
    __syncthreads();
    XcdBarrier bar = xcd_barrier_post(ctl + CW_BAR, (volatile LAS unsigned*)(lds + M_BARST));
#define GRID_SYNC() xcd_barrier(bar)

    bf16* HB = (bf16*)(ws + WS_HB); bf16* HB2 = (bf16*)(ws + WS_HB2);
    bf16* Qg = (bf16*)(ws + WS_Q); bf16* Kg = (bf16*)(ws + WS_K); bf16* Vt = (bf16*)(ws + WS_VT); bf16* YBUF = (bf16*)(ws + WS_YBUF);
    bf16* MIX = (bf16*)(ws + WS_MIX); bf16* U2 = (bf16*)(ws + WS_U2); bf16* YG = (bf16*)(ws + WS_YG);
    bf16* SCR = (bf16*)(ws + WS_SCR + (size_t)wg * SCR_PER_WG);
    float* CS = (float*)(ws + WS_CS); int* LIST = (int*)(ws + WS_LIST); float* SLOTW = (float*)(ws + WS_SLOTW);
    float* RINVM = (float*)(ws + WS_RINVM); float* ROWSS = (float*)(ws + WS_ROWSS); float* LAM16 = (float*)(ws + WS_LAM16); float* ATTSS = (float*)(ws + WS_ATTSS);

#if PH_MASK & 1
    for (int rep_ = 0; rep_ < REP_P0; ++rep_) {
        PHASE_IDS();
        const int gtid = wg * 512 + tid, gstride = G * 512;
        const int gwave = wg * 8 + wid, nwaves = G * 8;
        __syncthreads();
        { const int L = 0;
            unsigned char* wl = ws + WS_W + (size_t)L * LAYER_W;
            const float* gmix = (const float*)P.in[I_GMIX] + L * 1024; const float* win = (const float*)P.in[I_WIN] + (size_t)L * 1024 * 928;
            cvt_T(lds, 1024, 1024, (bf16*)(wl + OW_W1), [&](int n, int) -> const float* { if (n < 416) return win + n; if (n < 512) return nullptr; return win + 416 + (n - 512); }, [&](int, int) { return 928; },
                  [&](int k) { return gmix[k]; }, [&](int G32) { return G32 != 12; }, gwave, nwaves, lane, wid, 0);
            const float* gq = (const float*)P.in[I_GQ] + L * 256; const float* wq = (const float*)P.in[I_WQUP] + (size_t)L * 256 * 768;
            cvt_T(lds, 256, 768, (bf16*)(wl + OW_QN), [&](int n, int) -> const float* { return wq + n; }, [&](int, int) { return 768; }, [&](int k) { return gq[k]; }, [&](int G32) { return (G32 % 3) != 2; }, gwave, nwaves, lane, wid, 256);
            const float* gkv = (const float*)P.in[I_GKV] + L * 128; const float* wkv = (const float*)P.in[I_WKVUP] + (size_t)L * 128 * 1024;
            cvt_T(lds, 128, 512, (bf16*)(wl + OW_KN), [&](int n, int) -> const float* { return wkv + (n >> 6) * 128 + (n & 63); }, [&](int, int) { return 1024; }, [&](int k) { return gkv[k]; }, PermAll(), gwave, nwaves, lane, wid, 304);
            cvt_T(lds, 128, 512, (bf16*)(wl + OW_VV), [&](int n, int) -> const float* { return wkv + (n >> 6) * 128 + 64 + (n & 63); }, [&](int, int) { return 1024; }, [&](int k) { return gkv[k]; }, PermNone(), gwave, nwaves, lane, wid, 320);
            const float* wglu = (const float*)P.in[I_WGLU] + (size_t)L * 512 * 512;
            cvt_T(lds, 512, 512, (bf16*)(wl + OW_GLU), [&](int n, int) -> const float* { return wglu + n; }, [&](int, int) { return 512; }, [&](int) { return 1.f; }, PermAll(), gwave, nwaves, lane, wid, 336);
            const float* gmoe = (const float*)P.in[I_GMOE] + L * 1024; const float* wgr = (const float*)P.in[I_WGR] + (size_t)L * 1024 * 4; const float* wer = (const float*)P.in[I_WER] + (size_t)L * 1024 * 32;
            cvt_T(lds, 1024, 64, (bf16*)(wl + OW_WR), [&](int n, int) -> const float* { return n < 4 ? wgr + n : (n < 36 ? wer + (n - 4) : nullptr); }, [&](int n, int) { return n < 4 ? 4 : 32; },
                  [&](int k) { return gmoe[k]; }, PermNone(), gwave, nwaves, lane, wid, 400);
            const float* gat = (const float*)P.in[I_GATT] + L * 512; const float* gss = (const float*)P.in[I_GSSM] + L * 512; const float* wout = (const float*)P.in[I_WOUT] + (size_t)L * 1024 * 1024;
            cvt_T(lds, 1024, 1024, (bf16*)(wl + OW_OUT), [&](int n, int) -> const float* { return wout + n; }, [&](int, int) { return 1024; }, [&](int k) { return k < 512 ? gat[k] : gss[k - 512]; }, PermAll(), gwave, nwaves, lane, wid, 416);
            const float* gple = (const float*)P.in[I_GPLE] + L * 1024; const float* wpg = (const float*)P.in[I_WPG] + (size_t)L * 1024 * 1024; const float* wpp = (const float*)P.in[I_WPP] + (size_t)L * 256 * 1024;
            cvt_T(lds, 1280, 1024, (bf16*)(wl + OW_PGC), [&](int n, int k0) -> const float* { return (k0 < 256 ? wpp : wpg) + n; }, [&](int, int) { return 1024; },
                  [&](int k) { return k < 256 ? 1.f : gple[k - 256]; }, PermAll(), gwave, nwaves, lane, wid, 672, [&](int, int k0) { return k0 < 256 ? k0 : k0 - 256; });
        }
        {
            const int* pos = (const int*)P.in[I_POS];
            for (int idx = gtid; idx < T * 16; idx += gstride) {
                const int t = idx >> 4, i = idx & 15;
                const float inv = exp2f(-(float)i * (13.287712379549449f / 16.0f));
                float sn, cs; sincosf((float)pos[t] * inv, &sn, &cs);
                CS[(size_t)t * 32 + i] = cs; CS[(size_t)t * 32 + 16 + i] = sn;
            }
        }
        {
            const float* x = (const float*)P.in[I_X];
            for (int row0 = gwave * 4; row0 < T; row0 += nwaves * 4) {
                f32x4 v[4][4];
#pragma unroll
                for (int rr = 0; rr < 4; ++rr)
#pragma unroll
                    for (int j = 0; j < 4; ++j) v[rr][j] = ((const f32x4*)(x + (size_t)(row0 + rr) * 1024) + lane)[64 * j];
#pragma unroll
                for (int rr = 0; rr < 4; ++rr) { float sacc = 0.f;
#pragma unroll
                    for (int j = 0; j < 4; ++j) { const f32x4 w4 = v[rr][j]; sacc += w4[0] * w4[0] + w4[1] * w4[1] + w4[2] * w4[2] + w4[3] * w4[3];
                        *(u32x2*)(HB + (size_t)(row0 + rr) * 1024 + 256 * j + 4 * lane) = pack4(w4); }
#pragma unroll
                    for (int o = 1; o < 64; o <<= 1) sacc += __shfl_xor(sacc, o);
                    if (lane == 0) ROWSS[row0 + rr] = sacc; }
            }
        }
        for (int it = wg; it < DEPTH * 32 * 4; it += G) {
            const int u = it >> 2, part = it & 3, L = u >> 5, g = u & 31;
            unsigned char* wl = ws + WS_W + (size_t)L * LAYER_W;
            float* S5T = (float*)(ws + WS_S5T + (size_t)u * 40 * KiB);
            LAS float* pwr = (LAS float*)(lds + 0);
            LAS float* pwi = pwr + 17 * 64;
            LAS float* bpr = pwi + 17 * 64;
            LAS float* bpi = bpr + 1024;
            LAS float* ccr = bpi + 1024;
            LAS float* cci = ccr + 1024;
            __syncthreads();
            const float delta = __expf(((const float*)P.in[I_LOGSTEP])[L * 32 + g]);
            for (int e = tid; e < 17 * 64; e += 512) {
                const int k = e >> 6, p = e & 63;
                const float are = ((const float*)P.in[I_ARE])[(L * 32 + g) * 64 + p], aim = ((const float*)P.in[I_AIM])[(L * 32 + g) * 64 + p];
                const float mag = __expf(are * delta * (float)k); float sn, cs; sincosf(aim * delta * (float)k, &sn, &cs);
                pwr[e] = mag * cs; pwi[e] = mag * sn;
                if (part == 0) { S5T[4096 + e] = mag * cs; S5T[4096 + 1088 + e] = mag * sn;
                    if (k == 16) { LAM16[((size_t)(L * 32 + g) * 64 + p) * 2] = mag * cs; LAM16[((size_t)(L * 32 + g) * 64 + p) * 2 + 1] = mag * sn; } }
            }
            __syncthreads();
            for (int e = tid; e < 1024; e += 512) {
                const int p = e >> 4, hq = e & 15;
                const float are = ((const float*)P.in[I_ARE])[(L * 32 + g) * 64 + p], aim = ((const float*)P.in[I_AIM])[(L * 32 + g) * 64 + p];
                const float nr = pwr[64 + p] - 1.0f, ni = pwi[64 + p], den = are * are + aim * aim;
                const float fr = (nr * are + ni * aim) / den, fi = (ni * are - nr * aim) / den;
                const float br = ((const float*)P.in[I_BRE])[((size_t)(L * 32 + g) * 64 + p) * 16 + hq], bi = ((const float*)P.in[I_BIM])[((size_t)(L * 32 + g) * 64 + p) * 16 + hq];
                bpr[e] = fr * br - fi * bi; bpi[e] = fr * bi + fi * br;
                const int h2 = e >> 6, p2 = e & 63;
                const float c1 = ((const float*)P.in[I_CRE])[((size_t)(L * 32 + g) * 16 + h2) * 64 + p2], c2 = ((const float*)P.in[I_CIM])[((size_t)(L * 32 + g) * 16 + h2) * 64 + p2];
                ccr[e] = c1; cci[e] = c2;
                if (part == 0) { S5T[4096 + 2176 + e] = c1; S5T[4096 + 2176 + 1024 + e] = c2; }
            }
            __syncthreads();
            for (int e = part * 1024 + tid; e < part * 1024 + 1024; e += 512) {
                const int tau = e >> 8, hq = (e >> 4) & 15, hp = e & 15; float sacc = 0.f;
                for (int p = 0; p < 64; ++p) { const float wr = ccr[hq * 64 + p] * pwr[tau * 64 + p] - cci[hq * 64 + p] * pwi[tau * 64 + p], wi = ccr[hq * 64 + p] * pwi[tau * 64 + p] + cci[hq * 64 + p] * pwr[tau * 64 + p];
                    sacc += wr * bpr[p * 16 + hp] - wi * bpi[p * 16 + hp]; }
                S5T[e] = sacc;
            }
            bf16* Win = (bf16*)(wl + OW_SIN) + (size_t)g * 128 * 256;
            for (int e = part * 1024 + tid; e < part * 1024 + 1024; e += 512) {
                const int n = e >> 5, kc = e & 31, p = n & 63, sidx = kc >> 1, h0 = (kc & 1) * 8; float v[8];
#pragma unroll
                for (int j = 0; j < 8; ++j) { const float lr = pwr[(15 - sidx) * 64 + p], li = pwi[(15 - sidx) * 64 + p], br = bpr[p * 16 + h0 + j], bi = bpi[p * 16 + h0 + j];
                    v[j] = (n < 64) ? (lr * br - li * bi) : (lr * bi + li * br); }
                *(u32x4*)(Win + fm_off(n, kc * 8, 256)) = (u32x4){cvtpk(v[0], v[1]), cvtpk(v[2], v[3]), cvtpk(v[4], v[5]), cvtpk(v[6], v[7])};
            }
            __syncthreads();
        }
    }
#endif
    GRID_SYNC();

    for (int L = 0; L < DEPTH; ++L) {
        unsigned char* wl = ws + WS_W + (size_t)L * LAYER_W;
        const bf16 *W1 = (const bf16*)(wl + OW_W1), *WQN = (const bf16*)(wl + OW_QN), *WKN = (const bf16*)(wl + OW_KN), *WVV = (const bf16*)(wl + OW_VV),
                   *WGLU = (const bf16*)(wl + OW_GLU), *WR = (const bf16*)(wl + OW_WR), *WOUT = (const bf16*)(wl + OW_OUT), *WPGC = (const bf16*)(wl + OW_PGC),
                   *WSIN = (const bf16*)(wl + OW_SIN), *WSTW = (const bf16*)(wl + OW_STW), *WGU = (const bf16*)(wl + OW_GU), *WDN = (const bf16*)(wl + OW_DN);

        if (L == 0) {
            PHASE_IDS();
            for (int it = wg; it < DEPTH * 32 * 4; it += G) {
                const int u = it >> 2, part = it & 3, L2 = u >> 5, g = u & 31;
                const float* S5T = (const float*)(ws + WS_S5T + (size_t)u * 40 * KiB);
                LAS float* tb = (LAS float*)(lds + 0);
                __syncthreads();
                for (int e = tid; e < 4096 + 2176 + 2048; e += 512) tb[e] = S5T[e];
                __syncthreads();
                const LAS float* ktab = tb; const LAS float* pwr = tb + 4096; const LAS float* pwi = pwr + 1088; const LAS float* ccr = pwi + 1088; const LAS float* cci = ccr + 1024;
                bf16* TW = (bf16*)(ws + WS_W + (size_t)L2 * LAYER_W + OW_STW) + (size_t)g * 256 * 384;
                const float* sd = (const float*)P.in[I_SD] + (L2 * 32 + g) * 16;
                for (int e = part * 64 * 48 + tid; e < (part + 1) * 64 * 48; e += 512) {
                    const int n = e / 48, kc = e % 48, i = n >> 4, hq = n & 15; float v[8];
                    if (kc < 32) { const int sidx = kc >> 1, h0 = (kc & 1) * 8;
#pragma unroll
                        for (int j = 0; j < 8; ++j) { float x = (i >= sidx) ? ktab[((i - sidx) * 16 + hq) * 16 + h0 + j] : 0.f; if (i == sidx && hq == h0 + j) x += sd[hq]; v[j] = x; }
                    } else { const int p0 = (kc - 32) * 8;
#pragma unroll
                        for (int j = 0; j < 8; ++j) { const int p2 = p0 + j, p = p2 & 63; const float cr = ccr[hq * 64 + p], ci = cci[hq * 64 + p], lr = pwr[(i + 1) * 64 + p], li = pwi[(i + 1) * 64 + p];
                            v[j] = (p2 < 64) ? (cr * lr - ci * li) : -(cr * li + ci * lr); }
                    }
                    *(u32x4*)(TW + fm_off_p(n, kc * 8, 384)) = (u32x4){cvtpk(v[0], v[1]), cvtpk(v[2], v[3]), cvtpk(v[4], v[5]), cvtpk(v[6], v[7])};
                }
            }
            __syncthreads();
        }
#if PH_MASK & 2
        for (int rep_ = 0; rep_ < REP_P1; ++rep_)
        for (int tile = wg; tile < NTILE; tile += G) {
            PHASE_IDS();
            const int R0 = tile * 128;
            bf16* QLAT = SCR;
            bf16* KVLAT = SCR + 128 * 256;
            __syncthreads();
            if (tid < 128) { SF(0)[tid] = rsqrtf(ROWSS[R0 + tid] * (1.f / 1024.f) + EPS); }
            __syncthreads();
            bool xl_ok = (L == 0);
            gemm_rows<2, true>(lds, ALPlain{HB + (size_t)R0 * 1024, 1024}, W1, 1024, 4, 8, [&](int nt, f32x4 (&acc)[8][2], int w, int l15, int q) {
                if (!xl_ok) { unsigned* xl_ = ctl + CW_XL; XB_SPIN(xb_ld(xl_) < (unsigned)(G * L), ctl + CW_BAR); xl_ok = true; }
#pragma unroll
                for (int mf = 0; mf < 8; ++mf) {
                    const int row = mf * 16 + l15, tok = R0 + row; const float rv = SF(0)[row];
                    const int b = tok >> 11, t = tok & 2047;
                    if (nt == 0) {
                        const f32x4 v0 = acc[mf][0] * rv, v1 = acc[mf][1] * rv;
                        float ss = (v0[0] * v0[0] + v0[1] * v0[1] + v0[2] * v0[2] + v0[3] * v0[3]) + (v1[0] * v1[0] + v1[1] * v1[1] + v1[2] * v1[2] + v1[3] * v1[3]);
                        *(LAS u32x4*)(lds + LDS_B0 + (w >> 2) * 32768 + row * 256 + ((((w & 3) * 4 + q) ^ l15) << 4)) = pack8(v0, v1);
                        ss += __shfl_xor(ss, 16); ss += __shfl_xor(ss, 32);
                        if (q == 0) SF(8 + w)[row] = ss;
                    } else if (nt == 1) {
                        if (w < 4) {
                            const f32x4 v0 = acc[mf][0] * rv, v1 = acc[mf][1] * rv;
                            float ss = (v0[0] * v0[0] + v0[1] * v0[1] + v0[2] * v0[2] + v0[3] * v0[3]) + (v1[0] * v1[0] + v1[1] * v1[1] + v1[2] * v1[2] + v1[3] * v1[3]);
                            *(u32x4*)(KVLAT + row * 128 + w * 32 + 8 * q) = pack8(v0, v1);
                            ss += __shfl_xor(ss, 16); ss += __shfl_xor(ss, 32);
                            if (q == 0) SF(16 + w)[row] = ss;
                        } else if (w == 4) {
                            const f32x4 x1 = acc[mf][0] * rv, x2 = acc[mf][1] * rv;
                            const f32x4 c = *(const f32x4*)(CS + (size_t)tok * 32 + 4 * q), sn = *(const f32x4*)(CS + (size_t)tok * 32 + 16 + 4 * q);
                            const u32x2 o1 = pack4(x1 * c - x2 * sn), o2 = pack4(x1 * sn + x2 * c);
#pragma unroll
                            for (int h = 0; h < NH; ++h) { bf16* kp = Kg + (((size_t)b * NH + h) * SEQ + t) * 96 + 64 + 4 * q; *(u32x2*)kp = o1; *(u32x2*)(kp + 16) = o2; }
                        }
                    } else {
                        const int c16 = t >> 4, s16 = t & 15, cu = (nt - 2) * 256 + w * 32 + 8 * q, g = cu >> 4;
                        *(u32x4*)(U2 + ((size_t)g * 2048 + b * 128 + c16) * 256 + s16 * 16 + (cu & 15)) = pack8(acc[mf][0] * rv, acc[mf][1] * rv);
                    }
                }
            });
            if (tid < 128) { SF(1)[tid] = rsqrtf((((SF(8)[tid] + SF(9)[tid]) + (SF(10)[tid] + SF(11)[tid])) + ((SF(12)[tid] + SF(13)[tid]) + (SF(14)[tid] + SF(15)[tid]))) * (1.f / 256.f) + EPS);
                             SF(2)[tid] = rsqrtf(((SF(16)[tid] + SF(17)[tid]) + (SF(18)[tid] + SF(19)[tid])) * (1.f / 128.f) + EPS); }
            __syncthreads();
            const ALPlain Aq{QLAT, 256}, Akv{KVLAT, 128};
            gemm_rows<2, true, false, true>(lds, Aq, WQN, 256, 3, 8, [&](int nt, f32x4 (&acc)[8][2], int w, int l15, int q) {
                const int ch = nt * 8 + w, h = ch / 3, part = ch - 3 * h;
#pragma unroll
                for (int mf = 0; mf < 8; ++mf) { const int row = mf * 16 + l15, tok = R0 + row, b = tok >> 11, t = tok & 2047; const float rv = SF(1)[row] * QSCALE;
                    bf16* qp = Qg + (((size_t)b * NH + h) * SEQ + t) * 96 + part * 32 + 4 * q;
                    if (part < 2) { *(u32x4*)(qp + 4 * q) = pack8(acc[mf][0] * rv, acc[mf][1] * rv); }
                    else { const f32x4 c = *(const f32x4*)(CS + (size_t)tok * 32 + 4 * q), sn = *(const f32x4*)(CS + (size_t)tok * 32 + 16 + 4 * q);
                        const f32x4 x1 = acc[mf][0] * rv, x2 = acc[mf][1] * rv; *(u32x2*)qp = pack4(x1 * c - x2 * sn); *(u32x2*)(qp + 16) = pack4(x1 * sn + x2 * c); } }
            }, true, false);
            VM_WAIT(); __syncthreads();
            gemm_rows<2, true>(lds, Akv, WKN, 128, 2, 8, [&](int nt, f32x4 (&acc)[8][2], int w, int l15, int q) {
#pragma unroll
                for (int mf = 0; mf < 8; ++mf) { const int row = mf * 16 + l15, tok = R0 + row, b = tok >> 11, t = tok & 2047; const float rv = SF(2)[row];
                    const int col = nt * 256 + w * 32 + 8 * q, h = col >> 6, d = col & 63;
                    *(u32x4*)(Kg + (((size_t)b * NH + h) * SEQ + t) * 96 + d) = pack8(acc[mf][0] * rv, acc[mf][1] * rv); }
            });
            gemm_rows<2, false>(lds, Akv, WVV, 128, 2, 8, [&](int nt, f32x4 (&acc)[8][2], int w, int l15, int q) {
#pragma unroll
                for (int mf = 0; mf < 8; ++mf) { const int row0 = mf * 16 + 4 * q, tok0 = R0 + row0, b = tok0 >> 11, t0 = tok0 & 2047;
                    const f32x4 rv = *(const LAS f32x4*)(SF(2) + row0);
#pragma unroll
                    for (int nf = 0; nf < 2; ++nf) { const int col = nt * 256 + w * 32 + nf * 16 + l15, h = col >> 6, d = col & 63;
                        *(u32x2*)(Vt + (((size_t)b * NH + h) * 64 + d) * SEQ + t0) = pack4(acc[mf][nf] * rv); } }
            });
        }
#endif
        GRID_SYNC();

        const bool cvt_first = (wg & 8) == 0;
        if (L == 0 && cvt_first) { PHASE_IDS(); const int gwave = wg * 8 + wid, nwaves = G * 8; __syncthreads();
        { const int L = 0;
            unsigned char* wl = ws + WS_W + (size_t)L * LAYER_W; const float* gmoe = (const float*)P.in[I_GMOE] + L * 1024;
            const float* weg = (const float*)P.in[I_WEG] + (size_t)L * 32 * 1024 * 256; const float* weu = (const float*)P.in[I_WEU] + (size_t)L * 32 * 1024 * 256;
            cvt_T(lds, 1024, 32 * 512, (bf16*)(wl + OW_GU), [&](int n, int) -> const float* { const int e = n >> 9, np = n & 511, blk = np >> 5, up = (np >> 4) & 1, j = np & 15;
                      return (up ? weu : weg) + (size_t)e * 1024 * 256 + blk * 16 + j; }, [&](int, int) { return 256; }, [&](int k) { return gmoe[k]; }, PermNone(), gwave, nwaves, lane, wid);
            const float* wed = (const float*)P.in[I_WED] + (size_t)L * 32 * 256 * 1024;
            cvt_T(lds, 256, 32 * 1024, (bf16*)(wl + OW_DN), [&](int n, int) -> const float* { return wed + (size_t)(n >> 10) * 256 * 1024 + (n & 1023); }, [&](int, int) { return 1024; }, [&](int) { return 1.f; }, PermAll(), gwave, nwaves, lane, wid);
        }
        { const int L = 1;
            unsigned char* wl = ws + WS_W + (size_t)L * LAYER_W;
            const float* gmix = (const float*)P.in[I_GMIX] + L * 1024; const float* win = (const float*)P.in[I_WIN] + (size_t)L * 1024 * 928;
            cvt_T(lds, 1024, 1024, (bf16*)(wl + OW_W1), [&](int n, int) -> const float* { if (n < 416) return win + n; if (n < 512) return nullptr; return win + 416 + (n - 512); }, [&](int, int) { return 928; },
                  [&](int k) { return gmix[k]; }, [&](int G32) { return G32 != 12; }, gwave, nwaves, lane, wid, 0);
            const float* gq = (const float*)P.in[I_GQ] + L * 256; const float* wq = (const float*)P.in[I_WQUP] + (size_t)L * 256 * 768;
            cvt_T(lds, 256, 768, (bf16*)(wl + OW_QN), [&](int n, int) -> const float* { return wq + n; }, [&](int, int) { return 768; }, [&](int k) { return gq[k]; }, [&](int G32) { return (G32 % 3) != 2; }, gwave, nwaves, lane, wid, 256);
            const float* gkv = (const float*)P.in[I_GKV] + L * 128; const float* wkv = (const float*)P.in[I_WKVUP] + (size_t)L * 128 * 1024;
            cvt_T(lds, 128, 512, (bf16*)(wl + OW_KN), [&](int n, int) -> const float* { return wkv + (n >> 6) * 128 + (n & 63); }, [&](int, int) { return 1024; }, [&](int k) { return gkv[k]; }, PermAll(), gwave, nwaves, lane, wid, 304);
            cvt_T(lds, 128, 512, (bf16*)(wl + OW_VV), [&](int n, int) -> const float* { return wkv + (n >> 6) * 128 + 64 + (n & 63); }, [&](int, int) { return 1024; }, [&](int k) { return gkv[k]; }, PermNone(), gwave, nwaves, lane, wid, 320);
            const float* wglu = (const float*)P.in[I_WGLU] + (size_t)L * 512 * 512;
            cvt_T(lds, 512, 512, (bf16*)(wl + OW_GLU), [&](int n, int) -> const float* { return wglu + n; }, [&](int, int) { return 512; }, [&](int) { return 1.f; }, PermAll(), gwave, nwaves, lane, wid, 336);
            const float* gmoe = (const float*)P.in[I_GMOE] + L * 1024; const float* wgr = (const float*)P.in[I_WGR] + (size_t)L * 1024 * 4; const float* wer = (const float*)P.in[I_WER] + (size_t)L * 1024 * 32;
            cvt_T(lds, 1024, 64, (bf16*)(wl + OW_WR), [&](int n, int) -> const float* { return n < 4 ? wgr + n : (n < 36 ? wer + (n - 4) : nullptr); }, [&](int n, int) { return n < 4 ? 4 : 32; },
                  [&](int k) { return gmoe[k]; }, PermNone(), gwave, nwaves, lane, wid, 400);
            const float* gat = (const float*)P.in[I_GATT] + L * 512; const float* gss = (const float*)P.in[I_GSSM] + L * 512; const float* wout = (const float*)P.in[I_WOUT] + (size_t)L * 1024 * 1024;
            cvt_T(lds, 1024, 1024, (bf16*)(wl + OW_OUT), [&](int n, int) -> const float* { return wout + n; }, [&](int, int) { return 1024; }, [&](int k) { return k < 512 ? gat[k] : gss[k - 512]; }, PermAll(), gwave, nwaves, lane, wid, 416);
            const float* gple = (const float*)P.in[I_GPLE] + L * 1024; const float* wpg = (const float*)P.in[I_WPG] + (size_t)L * 1024 * 1024; const float* wpp = (const float*)P.in[I_WPP] + (size_t)L * 256 * 1024;
            cvt_T(lds, 1280, 1024, (bf16*)(wl + OW_PGC), [&](int n, int k0) -> const float* { return (k0 < 256 ? wpp : wpg) + n; }, [&](int, int) { return 1024; },
                  [&](int k) { return k < 256 ? 1.f : gple[k - 256]; }, PermAll(), gwave, nwaves, lane, wid, 672, [&](int, int k0) { return k0 < 256 ? k0 : k0 - 256; });
        }
            __syncthreads(); }
#if PH_MASK & 4
        for (int rep_ = 0; rep_ < REP_P2S; ++rep_)
        for (int u = wg; u < 512; u += G) {
            PHASE_IDS();
            const int g = u & 31, b = u >> 5;
            const bf16* Ua = U2 + ((size_t)g * 2048 + b * 128) * 256;
            bf16* XP = SCR;
            LAS float* SLm = (LAS float*)(lds + LDS_B0);
            __syncthreads();
            gemm_rows<1, true>(lds, ALPlain{Ua, 256}, WSIN + (size_t)g * 128 * 256, 256, 1, 8, [&](int, f32x4 (&acc)[8][1], int w, int l15, int q) {
#pragma unroll
                for (int mf = 0; mf < 8; ++mf) *(LAS f32x4*)(SLm + (mf * 16 + l15) * 128 + w * 16 + 4 * q) = acc[mf][0];
            });
            __syncthreads();
            {
                const int p = tid & 63, seg = tid >> 6;
                const float l16r = LAM16[((size_t)(L * 32 + g) * 64 + p) * 2], l16i = LAM16[((size_t)(L * 32 + g) * 64 + p) * 2 + 1];
                float xr = 0.f, xi = 0.f, lr[16], li[16];
#pragma unroll
                for (int j = 0; j < 16; ++j) { lr[j] = xr; li[j] = xi; const int c = seg * 16 + j;
                    const float sr = SLm[c * 128 + p], si = SLm[c * 128 + 64 + p];
                    const float nr = l16r * xr - l16i * xi + sr, ni = l16r * xi + l16i * xr + si; xr = nr; xi = ni; }
                float pr = l16r, pi = l16i;
#pragma unroll
                for (int j = 0; j < 4; ++j) { const float tr = pr * pr - pi * pi, ti = 2.f * pr * pi; pr = tr; pi = ti; }
                LAS float* TOT = (LAS float*)(lds + 0);
                TOT[(seg * 64 + p) * 2] = xr; TOT[(seg * 64 + p) * 2 + 1] = xi;
                __syncthreads();
                float cr = 0.f, ci = 0.f;
                for (int j = 0; j < seg; ++j) { const float tr = TOT[(j * 64 + p) * 2], ti = TOT[(j * 64 + p) * 2 + 1];
                    const float nr = pr * cr - pi * ci + tr, ni = pr * ci + pi * cr + ti; cr = nr; ci = ni; }
#pragma unroll
                for (int j = 0; j < 16; ++j) { const int c = seg * 16 + j;
                    XP[c * 128 + p] = (bf16)(cvtpk(lr[j] + cr, 0.f) & 0xffffu); XP[c * 128 + 64 + p] = (bf16)(cvtpk(li[j] + ci, 0.f) & 0xffffu);
                    const float nr = l16r * cr - l16i * ci, ni = l16r * ci + l16i * cr; cr = nr; ci = ni; }
            }
            BLOCK_SEAM();
            gemm_rows<2, true>(lds, ALTwo{Ua, 256, 256, XP, 128}, WSTW + (size_t)g * 256 * 384, 384, 1, 8, [&](int, f32x4 (&acc)[8][2], int w, int l15, int q) {
#pragma unroll
                for (int mf = 0; mf < 8; ++mf) { const int row = mf * 16 + l15;
                    const int col = w * 32 + 8 * q, i = col >> 4; const size_t tok = (size_t)b * SEQ + 16 * row + i; f32x4 v0 = acc[mf][0], v1 = acc[mf][1];
#pragma unroll
                    for (int r = 0; r < 4; ++r) { v0[r] = gelu_tanh(v0[r]); v1[r] = gelu_tanh(v1[r]); }
                    *(u32x4*)(YG + tok * 512 + g * 16 + (col & 15)) = pack8(v0, v1); }
            });
        }
#endif
#if PH_MASK & 8
        for (int rep_ = 0; rep_ < REP_P2A; ++rep_)
        for (int pr = vwg; pr < 512; pr += G) {
            const int bh = pr >> 2, s = pr & 3;
            __syncthreads();
            attn_unit(lds, bh >> 3, bh & 7, s, Qg, Kg, Vt, MIX, ATTSS);
            __syncthreads();
            attn_unit(lds, bh >> 3, bh & 7, 7 - s, Qg, Kg, Vt, MIX, ATTSS);
        }
#endif
        if (L == 0 && !cvt_first) { PHASE_IDS(); const int gwave = wg * 8 + wid, nwaves = G * 8; __syncthreads();
        { const int L = 0;
            unsigned char* wl = ws + WS_W + (size_t)L * LAYER_W; const float* gmoe = (const float*)P.in[I_GMOE] + L * 1024;
            const float* weg = (const float*)P.in[I_WEG] + (size_t)L * 32 * 1024 * 256; const float* weu = (const float*)P.in[I_WEU] + (size_t)L * 32 * 1024 * 256;
            cvt_T(lds, 1024, 32 * 512, (bf16*)(wl + OW_GU), [&](int n, int) -> const float* { const int e = n >> 9, np = n & 511, blk = np >> 5, up = (np >> 4) & 1, j = np & 15;
                      return (up ? weu : weg) + (size_t)e * 1024 * 256 + blk * 16 + j; }, [&](int, int) { return 256; }, [&](int k) { return gmoe[k]; }, PermNone(), gwave, nwaves, lane, wid);
            const float* wed = (const float*)P.in[I_WED] + (size_t)L * 32 * 256 * 1024;
            cvt_T(lds, 256, 32 * 1024, (bf16*)(wl + OW_DN), [&](int n, int) -> const float* { return wed + (size_t)(n >> 10) * 256 * 1024 + (n & 1023); }, [&](int, int) { return 1024; }, [&](int) { return 1.f; }, PermAll(), gwave, nwaves, lane, wid);
        }
        { const int L = 1;
            unsigned char* wl = ws + WS_W + (size_t)L * LAYER_W;
            const float* gmix = (const float*)P.in[I_GMIX] + L * 1024; const float* win = (const float*)P.in[I_WIN] + (size_t)L * 1024 * 928;
            cvt_T(lds, 1024, 1024, (bf16*)(wl + OW_W1), [&](int n, int) -> const float* { if (n < 416) return win + n; if (n < 512) return nullptr; return win + 416 + (n - 512); }, [&](int, int) { return 928; },
                  [&](int k) { return gmix[k]; }, [&](int G32) { return G32 != 12; }, gwave, nwaves, lane, wid, 0);
            const float* gq = (const float*)P.in[I_GQ] + L * 256; const float* wq = (const float*)P.in[I_WQUP] + (size_t)L * 256 * 768;
            cvt_T(lds, 256, 768, (bf16*)(wl + OW_QN), [&](int n, int) -> const float* { return wq + n; }, [&](int, int) { return 768; }, [&](int k) { return gq[k]; }, [&](int G32) { return (G32 % 3) != 2; }, gwave, nwaves, lane, wid, 256);
            const float* gkv = (const float*)P.in[I_GKV] + L * 128; const float* wkv = (const float*)P.in[I_WKVUP] + (size_t)L * 128 * 1024;
            cvt_T(lds, 128, 512, (bf16*)(wl + OW_KN), [&](int n, int) -> const float* { return wkv + (n >> 6) * 128 + (n & 63); }, [&](int, int) { return 1024; }, [&](int k) { return gkv[k]; }, PermAll(), gwave, nwaves, lane, wid, 304);
            cvt_T(lds, 128, 512, (bf16*)(wl + OW_VV), [&](int n, int) -> const float* { return wkv + (n >> 6) * 128 + 64 + (n & 63); }, [&](int, int) { return 1024; }, [&](int k) { return gkv[k]; }, PermNone(), gwave, nwaves, lane, wid, 320);
            const float* wglu = (const float*)P.in[I_WGLU] + (size_t)L * 512 * 512;
            cvt_T(lds, 512, 512, (bf16*)(wl + OW_GLU), [&](int n, int) -> const float* { return wglu + n; }, [&](int, int) { return 512; }, [&](int) { return 1.f; }, PermAll(), gwave, nwaves, lane, wid, 336);
            const float* gmoe = (const float*)P.in[I_GMOE] + L * 1024; const float* wgr = (const float*)P.in[I_WGR] + (size_t)L * 1024 * 4; const float* wer = (const float*)P.in[I_WER] + (size_t)L * 1024 * 32;
            cvt_T(lds, 1024, 64, (bf16*)(wl + OW_WR), [&](int n, int) -> const float* { return n < 4 ? wgr + n : (n < 36 ? wer + (n - 4) : nullptr); }, [&](int n, int) { return n < 4 ? 4 : 32; },
                  [&](int k) { return gmoe[k]; }, PermNone(), gwave, nwaves, lane, wid, 400);
            const float* gat = (const float*)P.in[I_GATT] + L * 512; const float* gss = (const float*)P.in[I_GSSM] + L * 512; const float* wout = (const float*)P.in[I_WOUT] + (size_t)L * 1024 * 1024;
            cvt_T(lds, 1024, 1024, (bf16*)(wl + OW_OUT), [&](int n, int) -> const float* { return wout + n; }, [&](int, int) { return 1024; }, [&](int k) { return k < 512 ? gat[k] : gss[k - 512]; }, PermAll(), gwave, nwaves, lane, wid, 416);
            const float* gple = (const float*)P.in[I_GPLE] + L * 1024; const float* wpg = (const float*)P.in[I_WPG] + (size_t)L * 1024 * 1024; const float* wpp = (const float*)P.in[I_WPP] + (size_t)L * 256 * 1024;
            cvt_T(lds, 1280, 1024, (bf16*)(wl + OW_PGC), [&](int n, int k0) -> const float* { return (k0 < 256 ? wpp : wpg) + n; }, [&](int, int) { return 1024; },
                  [&](int k) { return k < 256 ? 1.f : gple[k - 256]; }, PermAll(), gwave, nwaves, lane, wid, 672, [&](int, int k0) { return k0 < 256 ? k0 : k0 - 256; });
        }
            __syncthreads(); }
        GRID_SYNC();

        unsigned* CNT = ctl + CW_CNT + L * 32 * 64;
#if PH_MASK & 16
        for (int tile = wg; tile < NTILE; tile += G) {
            PHASE_IDS();
            const int R0 = tile * 128;
            __syncthreads();
            for (int i = tid; i < 16 * 128; i += 512) SF(8)[i] = 0.f;
            if (tid < 32) ((LAS int*)(lds + M_CNT))[tid] = 0;
            if (tid < 128) { float ss = 0.f;
#pragma unroll
                for (int hd = 0; hd < 8; ++hd) ss += ATTSS[(size_t)hd * T + R0 + tid];
                SF(1)[tid] = rsqrtf(ss * (1.f / 512.f) + EPS); }
            __syncthreads();
            const float* bglu = (const float*)P.in[I_BGLU] + L * 512;
            gemm_rows<2, true>(lds, ALPlain{YG + (size_t)R0 * 512, 512}, WGLU, 512, 2, 8, [&](int nt, f32x4 (&acc)[8][2], int w, int l15, int q) {
#pragma unroll
                for (int mf = 0; mf < 8; ++mf) { const int row = mf * 16 + l15; const size_t tok = R0 + row; float ss = 0.f;
                    const int col = nt * 256 + w * 32 + 8 * q; const u32x4 yw = *(const u32x4*)(YG + tok * 512 + col);
                    const f32x4 y0 = unpack4((u32x2){yw.x, yw.y}), y1 = unpack4((u32x2){yw.z, yw.w}), b0 = *(const f32x4*)(bglu + col), b1 = *(const f32x4*)(bglu + col + 4); f32x4 v0, v1;
#pragma unroll
                    for (int r = 0; r < 4; ++r) { v0[r] = y0[r] * sigmoidf_(acc[mf][0][r] + b0[r]); v1[r] = y1[r] * sigmoidf_(acc[mf][1][r] + b1[r]); ss += v0[r] * v0[r] + v1[r] * v1[r]; }
                    *(u32x4*)(MIX + tok * 1024 + 512 + col) = pack8(v0, v1);
                    ss += __shfl_xor(ss, 16); ss += __shfl_xor(ss, 32);
                    if (q == 0) SF(8 + w)[row] += ss; }
            });
            BLOCK_SEAM();
            if (tid < 128) { const float rs = rsqrtf((((SF(8)[tid] + SF(9)[tid]) + (SF(10)[tid] + SF(11)[tid])) + ((SF(12)[tid] + SF(13)[tid]) + (SF(14)[tid] + SF(15)[tid]))) * (1.f / 512.f) + EPS);
                SF(2)[tid] = rs; SF(4)[tid] = SF(1)[tid] / rs; }
            __syncthreads();
            gemm_rows<2, true>(lds, ALPlain{MIX + (size_t)R0 * 1024, 1024}, WOUT, 1024, 4, 8, [&](int nt, f32x4 (&acc)[8][2], int w, int l15, int q) {
#pragma unroll
                for (int mf = 0; mf < 8; ++mf) { const int row = mf * 16 + l15; const size_t tok = R0 + row; const float rs = SF(2)[row]; float ss = 0.f;
                    bf16* hp = HB + tok * 1024 + nt * 256 + w * 32 + 8 * q; const u32x4 hw = *(const u32x4*)hp;
                    const f32x4 v0 = unpack4((u32x2){hw.x, hw.y}) + acc[mf][0] * rs, v1 = unpack4((u32x2){hw.z, hw.w}) + acc[mf][1] * rs;
                    ss += (v0[0] * v0[0] + v0[1] * v0[1] + v0[2] * v0[2] + v0[3] * v0[3]) + (v1[0] * v1[0] + v1[1] * v1[1] + v1[2] * v1[2] + v1[3] * v1[3]); *(u32x4*)hp = pack8(v0, v1);
                    ss += __shfl_xor(ss, 16); ss += __shfl_xor(ss, 32);
                    if (q == 0) SF(16 + w)[row] += ss; }
            }, true, false, 3, [&](f32x4 (&acc)[8][2], int, int l15, int) {
#pragma unroll
                for (int mf = 0; mf < 8; ++mf) { const float r = SF(4)[mf * 16 + l15]; acc[mf][0] *= r; acc[mf][1] *= r; }
            });
            BLOCK_SEAM();
            if (tid < 128) { const float rv = rsqrtf((((SF(16)[tid] + SF(17)[tid]) + (SF(18)[tid] + SF(19)[tid])) + ((SF(20)[tid] + SF(21)[tid]) + (SF(22)[tid] + SF(23)[tid]))) * (1.f / 1024.f) + EPS); SF(3)[tid] = rv; RINVM[R0 + tid] = rv; }
            __syncthreads();
            {
                const float* bgr = (const float*)P.in[I_BGR] + L * 4; const float* ber = (const float*)P.in[I_BER] + L * 32;
                LAS float* LG = (LAS float*)(lds + M_LOG);
                gemm_rows<1, true, false, false, true>(lds, ALPlain{HB + (size_t)R0 * 1024, 1024}, WR, 1024, 1, 3, [&](int, f32x4 (&acc)[8][1], int w, int l15, int q) {
#pragma unroll
                    for (int mf = 0; mf < 8; ++mf) { const int row = mf * 16 + l15; const float rv = SF(3)[row];
#pragma unroll
                        for (int r = 0; r < 4; ++r) { const int col = w * 16 + 4 * q + r; if (col < 36) LG[row * 40 + col] = acc[mf][0][r] * rv + (col < 4 ? bgr[col] : ber[col - 4]); } }
                });
                __syncthreads();
                LAS int* sEID = (LAS int*)(lds + M_EID); LAS int* sRANK = (LAS int*)(lds + M_RANK); LAS float* sW2 = (LAS float*)(lds + M_W2);
                LAS int* sCNT = (LAS int*)(lds + M_CNT); LAS int* sBASE = (LAS int*)(lds + M_BASE);
                if (tid < 128) {
                    const LAS float* lg = LG + tid * 40;
                    float gm = lg[0]; int gi = 0;
#pragma unroll
                    for (int j = 1; j < 4; ++j) if (lg[j] > gm) { gm = lg[j]; gi = j; }
                    float gs = 0.f;
#pragma unroll
                    for (int j = 0; j < 4; ++j) gs += __expf(lg[j] - gm);
                    const float gp = 1.f / gs;
                    float e1 = -3.0e38f, e2 = -3.0e38f; int i1 = 0, i2 = 0;
#pragma unroll
                    for (int j = 0; j < 8; ++j) { const float v = lg[4 + gi * 8 + j]; if (v > e1) { e2 = e1; i2 = i1; e1 = v; i1 = j; } else if (v > e2) { e2 = v; i2 = j; } }
                    const float w1 = 1.f / (1.f + __expf(e2 - e1)), w2 = 1.f - w1;
                    const int E1 = gi * 8 + i1, E2 = gi * 8 + i2;
                    sEID[2 * tid] = E1; sEID[2 * tid + 1] = E2; sW2[2 * tid] = gp * w1; sW2[2 * tid + 1] = gp * w2;
                    sRANK[2 * tid] = atomicAdd((int*)(sCNT + E1), 1); sRANK[2 * tid + 1] = atomicAdd((int*)(sCNT + E2), 1);
                }
                __syncthreads();
                if (tid < 32) sBASE[tid] = (int)__hip_atomic_fetch_add(CNT + tid * 64, (unsigned)sCNT[tid], __ATOMIC_RELAXED, __HIP_MEMORY_SCOPE_AGENT);
                __syncthreads();
                if (tid < 256) { const int e = sEID[tid], pos = sBASE[e] + sRANK[tid], slot = R0 * 2 + tid; LIST[(size_t)e * 32768 + pos] = slot; SLOTW[slot] = sW2[tid]; }
            }
        }
#endif
        GRID_SYNC();

        if (L == 0 && cvt_first) { PHASE_IDS(); const int gwave = wg * 8 + wid, nwaves = G * 8; __syncthreads();
        { const int L = 1;
            unsigned char* wl = ws + WS_W + (size_t)L * LAYER_W; const float* gmoe = (const float*)P.in[I_GMOE] + L * 1024;
            const float* weg = (const float*)P.in[I_WEG] + (size_t)L * 32 * 1024 * 256; const float* weu = (const float*)P.in[I_WEU] + (size_t)L * 32 * 1024 * 256;
            cvt_T(lds, 1024, 32 * 512, (bf16*)(wl + OW_GU), [&](int n, int) -> const float* { const int e = n >> 9, np = n & 511, blk = np >> 5, up = (np >> 4) & 1, j = np & 15;
                      return (up ? weu : weg) + (size_t)e * 1024 * 256 + blk * 16 + j; }, [&](int, int) { return 256; }, [&](int k) { return gmoe[k]; }, PermNone(), gwave, nwaves, lane, wid);
            const float* wed = (const float*)P.in[I_WED] + (size_t)L * 32 * 256 * 1024;
            cvt_T(lds, 256, 32 * 1024, (bf16*)(wl + OW_DN), [&](int n, int) -> const float* { return wed + (size_t)(n >> 10) * 256 * 1024 + (n & 1023); }, [&](int, int) { return 1024; }, [&](int) { return 1.f; }, PermAll(), gwave, nwaves, lane, wid);
        }
            __syncthreads(); }
#if PH_MASK & 32
        for (int rep_ = 0; rep_ < REP_P4; ++rep_) {
            PHASE_IDS();
            LAS int* sECNT = (LAS int*)(lds + M_ECNT); LAS int* sTOK = (LAS int*)(lds + M_TOK); LAS int* sSLOT = (LAS int*)(lds + M_SLOT);
            LAS float* sWT = (LAS float*)(lds + M_WT); LAS float* sRV = (LAS float*)(lds + M_RV);
            __syncthreads();
            if (tid < 32) sECNT[tid] = (int)__hip_atomic_load(CNT + tid * 64, __ATOMIC_RELAXED, __HIP_MEMORY_SCOPE_AGENT);
            __syncthreads();
            int ctiles = 0;
            for (int e = 0; e < 32; ++e) ctiles += (sECNT[e] + 143) / 144;
            for (int gt = 2 * vwg; gt < ctiles; gt += 2 * G)
            for (int kk = 0; kk < 2; ++kk) {
                const int ti = gt + kk; if (ti >= ctiles) break;
                int e = 0, j = ti;
                for (; e < 32; ++e) { const int n = (sECNT[e] + 143) / 144; if (j < n) break; j -= n; }
                const int cnt = sECNT[e], ne = (cnt + 143) / 144, re = (cnt + ne - 1) / ne, off = j * re, rows = min(re, cnt - off), nmf = (rows + 15) >> 4;
                __syncthreads();
                if (tid < 144) { const bool valid = tid < rows; const int slot = LIST[(size_t)e * 32768 + off + (valid ? tid : 0)];
                    sTOK[tid] = slot >> 1; sSLOT[tid] = valid ? slot : -1; sWT[tid] = SLOTW[slot]; sRV[tid] = RINVM[slot >> 1]; }
                __syncthreads();
                gemm_moe<false>(lds, ALGather{HB, 1024, sTOK}, WGU + (size_t)e * 512 * 1024, 1024, 2, nmf, [&](int nt, f32x4 (&acc)[9][2], int w, int l15, int q) {
#pragma unroll
                    for (int mf = 0; mf < 9; ++mf) { if (mf >= nmf) break; const int row = mf * 16 + l15; const float rv = sRV[row];
                        const f32x4 gt_ = acc[mf][0] * rv, up = acc[mf][1] * rv; f32x4 hd;
#pragma unroll
                        for (int r = 0; r < 4; ++r) hd[r] = gt_[r] * sigmoidf_(gt_[r]) * up[r];
                        { const int j0 = (nt * 8 + w) * 16 + 4 * q;
                          *(LAS u32x2*)(lds + MOE_HD + (j0 >> 7) * MOE_STG + row * 256 + (((((j0 & 127) >> 3)) ^ (row & 15)) << 4) + (j0 & 7) * 2) = pack4(hd); } }
                });
                gemm_moe<true>(lds, ALPlain{HB, 256}, WDN + (size_t)e * 1024 * 256, 256, 4, nmf, [&](int nt, f32x4 (&acc)[9][2], int w, int l15, int q) {
#pragma unroll
                    for (int mf = 0; mf < 9; ++mf) { if (mf >= nmf) break; const int row = mf * 16 + l15; const int slot = sSLOT[row]; const float wt = sWT[row];
                        if (slot >= 0) *(u32x4*)(YBUF + (size_t)slot * 1024 + nt * 256 + w * 32 + 8 * q) = pack8(acc[mf][0] * wt, acc[mf][1] * wt); }
                });
                __syncthreads();
            }
        }
#endif
        if (L == 0 && !cvt_first) { PHASE_IDS(); const int gwave = wg * 8 + wid, nwaves = G * 8; __syncthreads();
        { const int L = 1;
            unsigned char* wl = ws + WS_W + (size_t)L * LAYER_W; const float* gmoe = (const float*)P.in[I_GMOE] + L * 1024;
            const float* weg = (const float*)P.in[I_WEG] + (size_t)L * 32 * 1024 * 256; const float* weu = (const float*)P.in[I_WEU] + (size_t)L * 32 * 1024 * 256;
            cvt_T(lds, 1024, 32 * 512, (bf16*)(wl + OW_GU), [&](int n, int) -> const float* { const int e = n >> 9, np = n & 511, blk = np >> 5, up = (np >> 4) & 1, j = np & 15;
                      return (up ? weu : weg) + (size_t)e * 1024 * 256 + blk * 16 + j; }, [&](int, int) { return 256; }, [&](int k) { return gmoe[k]; }, PermNone(), gwave, nwaves, lane, wid);
            const float* wed = (const float*)P.in[I_WED] + (size_t)L * 32 * 256 * 1024;
            cvt_T(lds, 256, 32 * 1024, (bf16*)(wl + OW_DN), [&](int n, int) -> const float* { return wed + (size_t)(n >> 10) * 256 * 1024 + (n & 1023); }, [&](int, int) { return 1024; }, [&](int) { return 1.f; }, PermAll(), gwave, nwaves, lane, wid);
        }
            __syncthreads(); }
        GRID_SYNC();

#if PH_MASK & 64
        for (int tile = wg; tile < NTILE; tile += G) {
            PHASE_IDS();
            const int R0 = tile * 128;
            bf16* PB = SCR;
            __syncthreads();
            for (int i = tid; i < 8 * 128; i += 512) SF(8)[i] = 0.f;
#pragma unroll 4
            for (int rr = 0; rr < 16; ++rr) { const int row = wid * 16 + rr; const size_t tok = R0 + row;
                const bf16* hp = HB + tok * 1024 + lane * 8; const bf16* y0 = YBUF + (2 * tok) * 1024 + lane * 8; bf16* op = HB2 + tok * 1024 + lane * 8;
                float ss = 0.f;
#pragma unroll
                for (int hf = 0; hf < 2; ++hf) { const u32x4 a = *(const u32x4*)(hp + 512 * hf), b = *(const u32x4*)(y0 + 512 * hf), c = *(const u32x4*)(y0 + 1024 + 512 * hf);
                    float v[8] = {bflo(a.x) + bflo(b.x) + bflo(c.x), bfhi(a.x) + bfhi(b.x) + bfhi(c.x), bflo(a.y) + bflo(b.y) + bflo(c.y), bfhi(a.y) + bfhi(b.y) + bfhi(c.y),
                                  bflo(a.z) + bflo(b.z) + bflo(c.z), bfhi(a.z) + bfhi(b.z) + bfhi(c.z), bflo(a.w) + bflo(b.w) + bflo(c.w), bfhi(a.w) + bfhi(b.w) + bfhi(c.w)};
#pragma unroll
                    for (int i = 0; i < 8; ++i) ss += v[i] * v[i];
                    *(u32x4*)(op + 512 * hf) = (u32x4){cvtpk(v[0], v[1]), cvtpk(v[2], v[3]), cvtpk(v[4], v[5]), cvtpk(v[6], v[7])}; }
#pragma unroll
                for (int o = 1; o < 64; o <<= 1) ss += __shfl_xor(ss, o);
                if (lane == 0) SF(0)[row] = rsqrtf(ss * (1.f / 1024.f) + EPS);
            }
            BLOCK_SEAM();
            LAS u32x2* STASH = (LAS u32x2*)(lds + LDS_B0);
            gemm_rows<2, true>(lds, ALF32Two{(const float*)P.in[I_P] + ((size_t)L * T + R0) * 256, 256, 256, HB2 + (size_t)R0 * 1024, 1024}, WPGC, 1280, 4, 8, [&](int nt, f32x4 (&acc)[8][2], int w, int l15, int q) {
#pragma unroll
                for (int mf = 0; mf < 8; ++mf) { const int row = mf * 16 + l15; const size_t tok = R0 + row; const float rv = SF(0)[row]; float ss = 0.f;
                    const int col = nt * 256 + w * 32 + 8 * q; const u32x4 hw = *(const u32x4*)(HB2 + tok * 1024 + col);
                    const f32x4 h20 = unpack4((u32x2){hw.x, hw.y}), h21 = unpack4((u32x2){hw.z, hw.w}), pp0 = unpack4(STASH[((w * 8 + mf) * 2 + 0) * 64 + q * 16 + l15]), pp1 = unpack4(STASH[((w * 8 + mf) * 2 + 1) * 64 + q * 16 + l15]);
                    f32x4 v0, v1;
#pragma unroll
                    for (int r = 0; r < 4; ++r) { v0[r] = h20[r] + pp0[r] * sigmoidf_(acc[mf][0][r] * rv); v1[r] = h21[r] + pp1[r] * sigmoidf_(acc[mf][1][r] * rv); ss += v0[r] * v0[r] + v1[r] * v1[r]; }
                    *(u32x4*)(HB + tok * 1024 + col) = pack8(v0, v1);
                    ss += __shfl_xor(ss, 16); ss += __shfl_xor(ss, 32);
                    if (q == 0) SF(8 + w)[row] += ss; }
            }, true, false, 1, [&](f32x4 (&acc)[8][2], int w, int l15, int q) {
#pragma unroll
                for (int mf = 0; mf < 8; ++mf)
#pragma unroll
                    for (int nf = 0; nf < 2; ++nf) { STASH[((w * 8 + mf) * 2 + nf) * 64 + q * 16 + l15] = pack4(acc[mf][nf]); acc[mf][nf] = (f32x4){0.f, 0.f, 0.f, 0.f}; }
            });
            BLOCK_SEAM();
            if (tid < 128) SF(2)[tid] = ((SF(8)[tid] + SF(9)[tid]) + (SF(10)[tid] + SF(11)[tid])) + ((SF(12)[tid] + SF(13)[tid]) + (SF(14)[tid] + SF(15)[tid]));
            __syncthreads();
            if (L + 1 < DEPTH) { if (tid < 128) ROWSS[R0 + tid] = SF(2)[tid]; }
            else {
                const float* gf = (const float*)P.in[I_GFIN];
                const f32x4 g0 = *(const f32x4*)(gf + lane * 8), g1 = *(const f32x4*)(gf + lane * 8 + 4), g2 = *(const f32x4*)(gf + 512 + lane * 8), g3 = *(const f32x4*)(gf + 512 + lane * 8 + 4);
#pragma unroll 4
                for (int rr = 0; rr < 16; ++rr) { const int row = wid * 16 + rr; const size_t tok = R0 + row;
                    const float rv = rsqrtf(SF(2)[row] * (1.f / 1024.f) + EPS);
                    const u32x4 a = *(const u32x4*)(HB + tok * 1024 + lane * 8), c = *(const u32x4*)(HB + tok * 1024 + 512 + lane * 8); float* op = P.out + tok * 1024 + lane * 8;
                    *(f32x4*)op = (f32x4){bflo(a.x) * rv * g0[0], bfhi(a.x) * rv * g0[1], bflo(a.y) * rv * g0[2], bfhi(a.y) * rv * g0[3]};
                    *(f32x4*)(op + 4) = (f32x4){bflo(a.z) * rv * g1[0], bfhi(a.z) * rv * g1[1], bflo(a.w) * rv * g1[2], bfhi(a.w) * rv * g1[3]};
                    *(f32x4*)(op + 512) = (f32x4){bflo(c.x) * rv * g2[0], bfhi(c.x) * rv * g2[1], bflo(c.y) * rv * g2[2], bfhi(c.y) * rv * g2[3]};
                    *(f32x4*)(op + 516) = (f32x4){bflo(c.z) * rv * g3[0], bfhi(c.z) * rv * g3[1], bflo(c.w) * rv * g3[2], bfhi(c.w) * rv * g3[3]}; }
            }
            BLOCK_SEAM();
        }
#endif
        if (L + 1 < DEPTH) { VM_WAIT(); __syncthreads(); if (threadIdx.x == 0) (void)xb_add(ctl + CW_XL, 1u); }
    }
}

extern "C" void kernel_launch(void* const* d_in, const int* in_sizes, int n_in, void* d_out, int out_size, void* d_ws, size_t ws_size, hipStream_t stream) {
    static int grid = 0;
    if (grid == 0) {
        if (n_in != 34 || out_size != T * DM || ws_size < WS_END) { fprintf(stderr, "kernel_launch: unexpected problem (n_in %d out %d ws %zu)\n", n_in, out_size, ws_size); grid = -1; return; }
        int dev = 0, cus = 0, per_cu = 0;
        (void)hipGetDevice(&dev);
        (void)hipDeviceGetAttribute(&cus, hipDeviceAttributeMultiprocessorCount, dev);
        if (hipFuncSetAttribute((const void*)mk_fwd, hipFuncAttributeMaxDynamicSharedMemorySize, LDS_TOTAL) != hipSuccess) { fprintf(stderr, "kernel_launch: hipFuncSetAttribute failed\n"); grid = -1; return; }
        if (hipOccupancyMaxActiveBlocksPerMultiprocessor(&per_cu, (const void*)mk_fwd, 512, LDS_TOTAL) != hipSuccess || per_cu < 1) { fprintf(stderr, "kernel_launch: occupancy query says %d blocks/CU\n", per_cu); (void)hipGetLastError(); per_cu = per_cu < 1 ? 0 : per_cu; }
        if (per_cu < 1 || cus < 1) { grid = -1; return; }
        grid = cus < NTILE ? cus : NTILE;
    }
    if (grid < 0) return;
    (void)hipMemsetAsync((char*)d_ws + WS_CTL, 0, CTL_BYTES, stream);
    Params p{};
    for (int i = 0; i < 34; ++i) p.in[i] = d_in[i];
    p.out = (float*)d_out; p.ws = (unsigned char*)d_ws;
    hipLaunchKernelGGL(mk_fwd, dim3(grid), dim3(512), LDS_TOTAL, stream, p);
}
```

```cpp
#include <hip/hip_runtime.h>
#include <cstdint>
#include <cstdio>

#ifndef NAIVE_GEMM
#define NAIVE_GEMM 0
#endif
#ifndef NAIVE_ATTN
#define NAIVE_ATTN 0
#endif
#ifndef PH_MASK
#define PH_MASK 127
#endif
#ifndef REP_P0
#define REP_P0 1
#endif
#ifndef REP_P1
#define REP_P1 1
#endif
#ifndef REP_P2S
#define REP_P2S 1
#endif
#ifndef REP_P2A
#define REP_P2A 1
#endif
#ifndef REP_P4
#define REP_P4 1
#endif
#ifndef USE_CG_SYNC
#define USE_CG_SYNC 0
#endif

#define LAS __attribute__((address_space(3)))
#define GAS __attribute__((address_space(1)))
typedef unsigned short bf16;
typedef short bf16x8 __attribute__((ext_vector_type(8)));
typedef float f32x4 __attribute__((ext_vector_type(4)));
typedef float f32x16 __attribute__((ext_vector_type(16)));
typedef unsigned u32x4 __attribute__((ext_vector_type(4)));
typedef unsigned u32x2 __attribute__((ext_vector_type(2)));
typedef LAS unsigned char* ldsp;

constexpr int T = 32768, DM = 1024, NB = 16, SEQ = 2048, DEPTH = 2, NH = 8;
constexpr int NTILE = T / 128;
constexpr float EPS = 1e-6f;
constexpr float QSCALE = 0.10206207261596577f * 1.4426950408889634f;

constexpr size_t KiB = 1024, MiB = 1024 * 1024;
constexpr size_t WS_CTL = 0, CTL_BYTES = 64 * KiB;
constexpr size_t WS_W = 1 * MiB, LAYER_W = 64 * MiB;
constexpr size_t OW_W1 = 0, OW_QN = 2048 * KiB  , OW_KN = 2432 * KiB, OW_VV = 2560 * KiB, OW_GLU = 2688 * KiB,
                 OW_WR = 3200 * KiB, OW_OUT = 3328 * KiB, OW_PGC = 5376 * KiB  , OW_SIN = 8192 * KiB, OW_STW = 10240 * KiB,
                 OW_GU = 16384 * KiB, OW_DN = 49152 * KiB;
constexpr size_t WS_HB = 129 * MiB;
constexpr size_t WS_R1 = 193 * MiB, WS_Q = WS_R1, WS_K = WS_R1 + 48 * MiB, WS_VT = WS_R1 + 96 * MiB, WS_YBUF = WS_R1;
constexpr size_t WS_MIX = 321 * MiB;
constexpr size_t WS_U2 = 385 * MiB, WS_YG = 417 * MiB, WS_HB2 = 385 * MiB;
constexpr size_t WS_SCR = 449 * MiB, SCR_PER_WG = 128 * KiB;
constexpr size_t WS_MISC = 481 * MiB;
constexpr size_t WS_CS = WS_MISC, WS_LIST = WS_MISC + 4 * MiB, WS_SLOTW = WS_MISC + 8 * MiB, WS_RINVM = WS_SLOTW + 256 * KiB,
                 WS_ROWSS = WS_RINVM + 128 * KiB, WS_LAM16 = WS_ROWSS + 128 * KiB, WS_S5T = WS_LAM16 + 64 * KiB, WS_ATTSS = WS_S5T + 64 * 40 * KiB, WS_END = WS_ATTSS + 8 * 128 * KiB;
static_assert(WS_END <= 512 * MiB, "ws map");
constexpr int CW_BAR = 1024;
constexpr int CW_CNT = 8192;
constexpr int CW_XL = 6144;
constexpr int LDS_B0 = 65536;
constexpr int LDS_MISC = 131072, LDS_TOTAL = LDS_MISC + 24576;
constexpr int M_F = LDS_MISC;
constexpr int M_LOG = LDS_B0;
constexpr int M_EID = LDS_MISC + 16384;
constexpr int M_RANK = M_EID + 1024;
constexpr int M_W2 = M_RANK + 1024;
constexpr int M_CNT = M_W2 + 1024;
constexpr int M_BASE = M_CNT + 128;
constexpr int M_ECNT = M_BASE + 128;
constexpr int M_TOK = M_ECNT + 128;
constexpr int M_SLOT = M_TOK + 640;
constexpr int M_WT = M_SLOT + 640;
constexpr int M_RV = M_WT + 640;
constexpr int M_BARST = M_RV + 640;
constexpr int MOE_STG = 36864, MOE_HD = 2 * MOE_STG;
static_assert(MOE_HD + 2 * MOE_STG <= M_EID, "expert-phase LDS image must end below the integer arrays");
static_assert(M_BARST + 16 <= LDS_TOTAL && LDS_TOTAL <= 163840, "lds map");

typedef float f32x2_t __attribute__((ext_vector_type(2)));
typedef __bf16 bf16x2_t __attribute__((ext_vector_type(2)));
__device__ __forceinline__ unsigned cvtpk(float lo, float hi) { f32x2_t v = {lo, hi}; bf16x2_t b = __builtin_convertvector(v, bf16x2_t); return __builtin_bit_cast(unsigned, b); }
__device__ __forceinline__ float bflo(unsigned w) { return __uint_as_float(w << 16); }
__device__ __forceinline__ float bfhi(unsigned w) { return __uint_as_float(w & 0xffff0000u); }
__device__ __forceinline__ float bf2f(bf16 b) { return __uint_as_float(((unsigned)b) << 16); }
__device__ __forceinline__ u32x2 pack4(f32x4 v) { u32x2 r; r.x = cvtpk(v[0], v[1]); r.y = cvtpk(v[2], v[3]); return r; }
__device__ __forceinline__ u32x4 pack8(f32x4 a, f32x4 b) { u32x4 r; r.x = cvtpk(a[0], a[1]); r.y = cvtpk(a[2], a[3]); r.z = cvtpk(b[0], b[1]); r.w = cvtpk(b[2], b[3]); return r; }
__device__ __forceinline__ f32x4 unpack4(u32x2 w) { f32x4 r; r[0] = bflo(w.x); r[1] = bfhi(w.x); r[2] = bflo(w.y); r[3] = bfhi(w.y); return r; }
constexpr float Y8_INV = 1.f;
typedef float f32x2 __attribute__((ext_vector_type(2)));
typedef _Float16 f16x2 __attribute__((ext_vector_type(2)));
__device__ __forceinline__ unsigned y8enc(f32x4 a) {
    const unsigned h01 = __builtin_bit_cast(unsigned, __builtin_amdgcn_cvt_pkrtz(a[0], a[1])) + 0x00800080u, h23 = __builtin_bit_cast(unsigned, __builtin_amdgcn_cvt_pkrtz(a[2], a[3])) + 0x00800080u;
    return __builtin_amdgcn_perm(h23, h01, 0x07050301u); }
__device__ __forceinline__ f32x2 y8lo(unsigned v) { const f16x2 h = __builtin_bit_cast(f16x2, __builtin_amdgcn_perm(0u, v, 0x010c000cu)); return (f32x2){(float)h[0], (float)h[1]}; }
__device__ __forceinline__ f32x2 y8hi(unsigned v) { const f16x2 h = __builtin_bit_cast(f16x2, __builtin_amdgcn_perm(0u, v, 0x030c020cu)); return (f32x2){(float)h[0], (float)h[1]}; }
__device__ __forceinline__ float sigmoidf_(float x) { return __builtin_amdgcn_rcpf(1.0f + __builtin_amdgcn_exp2f(-1.4426950408889634f * x)); }
__device__ __forceinline__ float gelu_tanh(float x) { const float u = 0.7978845608028654f * (x + 0.044715f * x * x * x);
    return x * __builtin_amdgcn_rcpf(1.0f + __builtin_amdgcn_exp2f(-2.8853900817779268f * u)); }
#define VM_WAIT() asm volatile("s_waitcnt vmcnt(0)" ::: "memory")
#define BLOCK_SEAM() do { VM_WAIT(); __syncthreads(); } while (0)

#define XB_TMO      128
#define XB_XCNT(j)  (256  + 64 * (j))
#define XB_XSUB(j)  (1280 + 64 * (j))
#define XB_XGEN(j)  (2304 + 64 * (j))
#define XB_TOP      3328
#define XB_TOPGEN   3392
#define XCD_BAR_WORDS 3456
#define XB_SPIN_CAP (1u << 20)
__device__ __forceinline__ unsigned xb_ld(unsigned* p)              { return __hip_atomic_load(p, __ATOMIC_RELAXED, __HIP_MEMORY_SCOPE_AGENT); }
__device__ __forceinline__ unsigned xb_add(unsigned* p, unsigned v) { return __hip_atomic_fetch_add(p, v, __ATOMIC_RELAXED, __HIP_MEMORY_SCOPE_AGENT); }
__device__ __forceinline__ unsigned xb_xcc_id() { return (unsigned)__builtin_amdgcn_s_getreg((3 << 11) | 20) & 0xFu; }
#define XB_SPIN(cond, bar) do { unsigned _sp = 0; while (cond) { __builtin_amdgcn_s_sleep(1); \
    if ((++_sp & 255u) == 0u) { if (xb_ld(&(bar)[XB_TMO])) break; if (_sp > XB_SPIN_CAP) { atomicAdd(&(bar)[XB_TMO], 1u); break; } } } } while (0)
struct XcdBarrier { unsigned* bar; unsigned x; volatile LAS unsigned* st; };
__device__ __forceinline__ XcdBarrier xcd_barrier_post(unsigned* bar, volatile LAS unsigned* st) {
    XcdBarrier b; b.bar = bar; b.x = xb_xcc_id(); b.st = st;
    if (threadIdx.x == 0) (void)xb_add(&bar[XB_XCNT(b.x)], 1u);
    return b;
}
__device__ __forceinline__ void xcd_barrier_complete(unsigned* bar, unsigned x, unsigned& nloc, unsigned& nx) {
    const unsigned G = gridDim.x * gridDim.y * gridDim.z;
    unsigned sum, cnt, mine, sp = 0u;
    for (;;) {
        sum = 0u; cnt = 0u; mine = 0u;
#pragma unroll
        for (unsigned j = 0; j < 16; ++j) { const unsigned c = xb_ld(&bar[XB_XCNT(j)]); sum += c; cnt += (c > 0u) ? 1u : 0u; mine = (j == x) ? c : mine; }
        if (sum == G) break;
        __builtin_amdgcn_s_sleep(1);
        if ((++sp & 255u) == 0u) { if (xb_ld(&bar[XB_TMO])) break; if (sp > XB_SPIN_CAP) { atomicAdd(&bar[XB_TMO], 1u); break; } }
    }
    nloc = mine > 0u ? mine : 1u; nx = cnt > 0u ? cnt : 1u;
}
__device__ __forceinline__ void xcd_barrier(const XcdBarrier& b) {
    asm volatile("s_waitcnt vmcnt(0)" ::: "memory");
    __syncthreads();
    if (threadIdx.x == 0) {
        unsigned* bar = b.bar;
        __builtin_amdgcn_s_waitcnt(0);
        unsigned nloc = b.st[0], nx = b.st[1];
        if (nloc == 0u) { xcd_barrier_complete(bar, b.x, nloc, nx); b.st[0] = nloc; b.st[1] = nx; }
        const unsigned old = xb_add(&bar[XB_XSUB(b.x)], 1u);
        const unsigned gen = old / nloc;
        if (old + 1u == (gen + 1u) * nloc) {
            __builtin_amdgcn_fence(__ATOMIC_RELEASE, "agent");
            asm volatile("s_waitcnt vmcnt(0)" ::: "memory");
            const unsigned og = xb_add(&bar[XB_TOP], 1u);
            const unsigned tg = og / nx;
            if (og + 1u == (tg + 1u) * nx) xb_add(&bar[XB_TOPGEN], 1u);
            else XB_SPIN(xb_ld(&bar[XB_TOPGEN]) == tg, bar);
            __builtin_amdgcn_fence(__ATOMIC_ACQUIRE, "agent");
            xb_add(&bar[XB_XGEN(b.x)], 1u);
            asm volatile("s_waitcnt vmcnt(0)" ::: "memory");
        } else {
            XB_SPIN(xb_ld(&bar[XB_XGEN(b.x)]) == gen, bar);
            __builtin_amdgcn_fence(__ATOMIC_ACQUIRE, "agent");
            asm volatile("s_waitcnt vmcnt(0)" ::: "memory");
        }
    }
    __syncthreads();
}

struct ALPlain { const bf16* p; int ld; __device__ __forceinline__ const bf16* ptr(int row, int k) const { return p + (size_t)row * ld + k; }
    __device__ __forceinline__ u32x4 load(int row, int k) const { return *(const u32x4*)ptr(row, k); } };
struct ALTwo { const bf16* p0; int ld0; int k0; const bf16* p1; int ld1;
    __device__ __forceinline__ const bf16* ptr(int row, int k) const { return (k < k0) ? p0 + (size_t)row * ld0 + k : p1 + (size_t)row * ld1 + (k - k0); }
    __device__ __forceinline__ u32x4 load(int row, int k) const { return *(const u32x4*)ptr(row, k); } };
struct ALF32Two { const float* p0; int ld0; int k0; const bf16* p1; int ld1;
    __device__ __forceinline__ u32x4 load(int row, int k) const {
        if (k < k0) { const f32x4 a = *(const f32x4*)(p0 + (size_t)row * ld0 + k), b = *(const f32x4*)(p0 + (size_t)row * ld0 + k + 4); return pack8(a, b); }
        return *(const u32x4*)(p1 + (size_t)row * ld1 + (k - k0)); } };
struct ALGather { const bf16* p; int ld; const LAS int* rows;
    __device__ __forceinline__ const bf16* ptr(int row, int k) const { return p + (size_t)rows[row] * ld + k; }
    __device__ __forceinline__ u32x4 load(int row, int k) const { return *(const u32x4*)ptr(row, k); } };


__device__ __forceinline__ float dot8(u32x4 a, u32x4 b) {
    return bflo(a.x) * bflo(b.x) + bfhi(a.x) * bfhi(b.x) + bflo(a.y) * bflo(b.y) + bfhi(a.y) * bfhi(b.y) + bflo(a.z) * bflo(b.z) + bfhi(a.z) * bfhi(b.z) + bflo(a.w) * bflo(b.w) + bfhi(a.w) * bfhi(b.w);
}
__device__ __forceinline__ size_t fm_off(int n, int k, int K) { return ((size_t)((n >> 4) * (K >> 5) + (k >> 5)) << 9) + (size_t)(((((k & 31) >> 3) << 4) + (n & 15)) << 3) + (k & 7); }

__device__ __forceinline__ size_t fm_off_p(int n, int k, int K) { const int sl = n & 31; return fm_off((n & ~31) + ((sl >> 2) & 1) * 16 + 4 * (sl >> 3) + (sl & 3), k, K); }
struct NoHook { template <class T> __device__ __forceinline__ void operator()(T&, int, int, int) const {} };
template <int NFW, bool SWAP, bool MHALF = false, bool ARES = false, bool SKIPI = false, class AL, class Epi, class Hook = NoHook>
__device__ __forceinline__ void gemm_rows(ldsp lds, const AL& A, const bf16* __restrict__ Bfm, int K, int NT, int nactive, const Epi& epi, bool full = true, bool rotk = true, int khook = -1, const Hook& hook = NoHook()) {
    int tid = threadIdx.x; asm volatile("" : "+v"(tid));
    const int lane = tid & 63, w = __builtin_amdgcn_readfirstlane(tid >> 6), l15 = lane & 15, q = lane >> 4;
    const bool act = w < nactive;
    const int wc = act ? w : nactive - 1;
    f32x4 acc[8][NFW];
#pragma unroll
    for (int m = 0; m < 8; ++m)
#pragma unroll
        for (int n = 0; n < NFW; ++n) acc[m][n] = (f32x4){0.f, 0.f, 0.f, 0.f};
    const int nk = K >> 7, KB = K >> 5, total = NT * nk;
    u32x4 ra[2][4], rb[2][NFW][4];
    const int ar0 = tid >> 4, ac = (tid & 15) * 8;
    const int aw0 = ar0 * 256 + (((tid & 15) ^ (ar0 & 15)) << 4);
    const bf16* bw = Bfm + (size_t)wc * NFW * KB * 512 + lane * 8;
    const int rot1 = (int)(blockIdx.x >> 3) % NT, rot2 = rotk ? (int)(blockIdx.x >> 5) % nk : 0;
    int nti = 0, kti = 0, ktia = 0;
#define G_ADDR_A() int ktra_ = ktia + rot2; if (ktra_ >= nk) ktra_ -= nk; const int k0_ = ktra_ * 128 + ac; if (++ktia == nk) ktia = 0;
#define G_ADDR_B() int ntr_ = nti + rot1; if (ntr_ >= NT) ntr_ -= NT; int ktr_ = kti + rot2; if (ktr_ >= nk) ktr_ -= nk; \
        const bf16* bp_ = bw + ((size_t)ntr_ * 8 * NFW * KB + ktr_ * 4) * 512; \
        if (kti + 1 < nk) ++kti; else if (nti + 1 < NT) { kti = 0; ++nti; }
#define G_LA(st, i_) do { if (!ARES) ra[st][i_] = A.load(ar0 + 32 * (i_), k0_); } while (0)
#define G_SA(st, stg, i_) do { if (!ARES) *(LAS u32x4*)(lds + (stg) * 32768 + aw0 + (i_) * 8192) = ra[st][i_]; } while (0)
#define G_LB(sb, j_) do { if ((j_) < NFW * 4) { if (!SKIPI || act) rb[sb][(j_) >> 2][(j_) & 3] = *(const u32x4*)(bp_ + ((size_t)((j_) >> 2) * KB + ((j_) & 3)) * 512); } } while (0)
#define G_PIECE(sa_, g_) do { if ((g_) == 0) { G_LA(sa_, 0); G_LA(sa_, 1); } else if ((g_) == 1) { G_LA(sa_, 2); G_LA(sa_, 3); } \
        else if ((g_) == 2) { G_LB(1 - (sa_), 0); if (NFW == 2) G_LB(1 - (sa_), 4); G_SA(1 - (sa_), 1 - (sa_), 0); } \
        else if ((g_) == 3) { G_LB(1 - (sa_), 1); G_SA(1 - (sa_), 1 - (sa_), 1); } else if ((g_) == 4) { G_LB(1 - (sa_), 2); if (NFW == 2) G_LB(1 - (sa_), 5); G_SA(1 - (sa_), 1 - (sa_), 2); } \
        else if ((g_) == 5) { G_LB(1 - (sa_), 3); G_SA(1 - (sa_), 1 - (sa_), 3); } else if ((g_) == 6) { if (NFW == 2) G_LB(1 - (sa_), 6); } else { if (NFW == 2) G_LB(1 - (sa_), 7); } } while (0)
    int nt = 0, kt = 0;
#define G_STEP(sa) { G_ADDR_A(); G_ADDR_B(); \
        if (SKIPI && !act) { G_LA(sa, 0); G_LA(sa, 1); G_LA(sa, 2); G_LA(sa, 3); G_SA(1 - (sa), 1 - (sa), 0); G_SA(1 - (sa), 1 - (sa), 1); G_SA(1 - (sa), 1 - (sa), 2); G_SA(1 - (sa), 1 - (sa), 3); } else \
        { const ldsp a_ = (ARES ? lds + LDS_B0 + kt * 32768 : lds + (sa) * 32768) + l15 * 256; bf16x8 af[2][4]; \
            _Pragma("unroll") for (int m = 0; m < 4; ++m) af[0][m] = *(const LAS bf16x8*)(a_ + m * 4096 + ((q ^ l15) << 4)); \
            _Pragma("unroll") for (int g = 0; g < 8; ++g) { const int ks = g >> 1, mh = (g & 1) * 4; \
                if (g < 7) { const int ks1 = (g + 1) >> 1, mh1 = ((g + 1) & 1) * 4; \
                    if (!MHALF || mh1 == 0 || full) { _Pragma("unroll") for (int m = 0; m < 4; ++m) af[(g + 1) & 1][m] = *(const LAS bf16x8*)(a_ + (mh1 + m) * 4096 + (((ks1 * 4 + q) ^ l15) << 4)); } } \
                __builtin_amdgcn_sched_barrier(0); \
                G_PIECE(sa, g); __builtin_amdgcn_sched_barrier(0); \
                if (!MHALF || mh == 0 || full) { \
                _Pragma("unroll") for (int m = 0; m < 4; ++m) _Pragma("unroll") for (int n = 0; n < NFW; ++n) \
                    acc[mh + m][n] = SWAP ? __builtin_amdgcn_mfma_f32_16x16x32_bf16(__builtin_bit_cast(bf16x8, rb[sa][n][ks]), af[g & 1][m], acc[mh + m][n], 0, 0, 0) \
                                          : __builtin_amdgcn_mfma_f32_16x16x32_bf16(af[g & 1][m], __builtin_bit_cast(bf16x8, rb[sa][n][ks]), acc[mh + m][n], 0, 0, 0); } \
                __builtin_amdgcn_sched_barrier(0); } } \
        if (kt == khook) { if (act) { int l15h = l15, qh = q; asm volatile("" : "+v"(l15h), "+v"(qh)); hook(acc, w, l15h, qh); } } \
        if (++kt == nk) { kt = 0; \
            if (act) { int l15e = l15, qe = q; asm volatile("" : "+v"(l15e), "+v"(qe)); epi((nt + rot1 >= NT) ? nt + rot1 - NT : nt + rot1, acc, w, l15e, qe); } \
            _Pragma("unroll") for (int m = 0; m < 8; ++m) _Pragma("unroll") for (int n = 0; n < NFW; ++n) acc[m][n] = (f32x4){0.f, 0.f, 0.f, 0.f}; \
            ++nt; } \
        __syncthreads(); }
    {
        { G_ADDR_A(); G_LA(0, 0); G_LA(0, 1); G_LA(0, 2); G_LA(0, 3); }
        { G_ADDR_A(); G_LA(1, 0); G_LA(1, 1); G_LA(1, 2); G_LA(1, 3); }
        { G_ADDR_B(); G_LB(0, 0); G_LB(0, 1); G_LB(0, 2); G_LB(0, 3); G_LB(0, 4); G_LB(0, 5); G_LB(0, 6); G_LB(0, 7); }
        G_SA(0, 0, 0); G_SA(0, 0, 1); G_SA(0, 0, 2); G_SA(0, 0, 3);
        __syncthreads();
    }
    int s = 0;
    for (; s + 1 < total; s += 2) { G_STEP(0) G_STEP(1) }
    if (s < total) G_STEP(0)
#undef G_ADDR_A
#undef G_ADDR_B
#undef G_LA
#undef G_SA
#undef G_LB
#undef G_PIECE
#undef G_STEP
}

template <bool ARES, class AL, class Epi>
__device__ __forceinline__ void gemm_moe(ldsp lds, const AL& A, const bf16* __restrict__ Bfm, int K, int NT, int nmf, const Epi& epi) {
    int tid = threadIdx.x; asm volatile("" : "+v"(tid));
    const int lane = tid & 63, w = __builtin_amdgcn_readfirstlane(tid >> 6), l15 = lane & 15, q = lane >> 4;
    f32x4 acc[9][2];
#pragma unroll
    for (int m = 0; m < 9; ++m) { acc[m][0] = (f32x4){0.f, 0.f, 0.f, 0.f}; acc[m][1] = (f32x4){0.f, 0.f, 0.f, 0.f}; }
    const int nk = K >> 7, KB = K >> 5, total = NT * nk;
    u32x4 ra[2][5], rb[2][2][4];
    const int ar0 = tid >> 4, ac = (tid & 15) * 8;
    const int aw0 = ar0 * 256 + (((tid & 15) ^ (ar0 & 15)) << 4);
    const bool a4 = tid < 256;
    const bf16* bw = Bfm + (size_t)w * 2 * KB * 512 + lane * 8;
    int nti = 0, kti = 0, ktia = 0;
#define M_ADDR_A() const int k0_ = ktia * 128 + ac; if (++ktia == nk) ktia = 0;
#define M_ADDR_B() const bf16* bp_ = bw + ((size_t)nti * 16 * KB + kti * 4) * 512; if (kti + 1 < nk) ++kti; else if (nti + 1 < NT) { kti = 0; ++nti; }
#define M_LA(st, i_) do { if (!ARES) { if ((i_) < 4 || a4) ra[st][i_] = A.load(ar0 + 32 * (i_), k0_); } } while (0)
#define M_SA(st, stg, i_) do { if (!ARES) { if ((i_) < 4 || a4) *(LAS u32x4*)(lds + (stg) * MOE_STG + aw0 + (i_) * 8192) = ra[st][i_]; } } while (0)
#define M_LB(sb, j_) do { rb[sb][(j_) >> 2][(j_) & 3] = *(const u32x4*)(bp_ + ((size_t)((j_) >> 2) * KB + ((j_) & 3)) * 512); } while (0)
#define M_PIECE(sa_, g_) do { if ((g_) == 0) { M_LA(sa_, 0); M_LA(sa_, 1); } else if ((g_) == 1) { M_LA(sa_, 2); M_LA(sa_, 3); } else if ((g_) == 2) { M_LA(sa_, 4); } \
        else if ((g_) == 3) { M_LB(1 - (sa_), 0); M_LB(1 - (sa_), 4); } else if ((g_) == 4) { M_LB(1 - (sa_), 1); M_SA(1 - (sa_), 1 - (sa_), 0); } else if ((g_) == 5) { M_LB(1 - (sa_), 2); M_SA(1 - (sa_), 1 - (sa_), 1); } \
        else if ((g_) == 6) { M_LB(1 - (sa_), 5); M_SA(1 - (sa_), 1 - (sa_), 2); } else if ((g_) == 7) { M_LB(1 - (sa_), 3); M_SA(1 - (sa_), 1 - (sa_), 3); } else if ((g_) == 8) { M_LB(1 - (sa_), 6); M_SA(1 - (sa_), 1 - (sa_), 4); } \
        else if ((g_) == 9) { M_LB(1 - (sa_), 7); } } while (0)
    int nt = 0, kt = 0;
#define M_STEP(sa) { M_ADDR_A(); M_ADDR_B(); \
        { const ldsp a_ = (ARES ? lds + MOE_HD + kt * MOE_STG : lds + (sa) * MOE_STG) + l15 * 256; bf16x8 af[2][3]; \
            _Pragma("unroll") for (int m = 0; m < 3; ++m) af[0][m] = *(const LAS bf16x8*)(a_ + m * 4096 + ((q ^ l15) << 4)); \
            _Pragma("unroll") for (int g = 0; g < 12; ++g) { const int ks = g / 3, mb = (g % 3) * 3; \
                if (g < 11) { const int ks1 = (g + 1) / 3, mb1 = ((g + 1) % 3) * 3; \
                    if (mb1 < nmf) { _Pragma("unroll") for (int m = 0; m < 3; ++m) af[(g + 1) & 1][m] = *(const LAS bf16x8*)(a_ + (mb1 + m) * 4096 + (((ks1 * 4 + q) ^ l15) << 4)); } } \
                __builtin_amdgcn_sched_barrier(0); \
                M_PIECE(sa, g); __builtin_amdgcn_sched_barrier(0); \
                if (mb < nmf) { \
                _Pragma("unroll") for (int m = 0; m < 3; ++m) _Pragma("unroll") for (int n = 0; n < 2; ++n) \
                    acc[mb + m][n] = __builtin_amdgcn_mfma_f32_16x16x32_bf16(__builtin_bit_cast(bf16x8, rb[sa][n][ks]), af[g & 1][m], acc[mb + m][n], 0, 0, 0); } \
                __builtin_amdgcn_sched_barrier(0); } } \
        if (++kt == nk) { kt = 0; \
            { int l15e = l15, qe = q; asm volatile("" : "+v"(l15e), "+v"(qe)); epi(nt, acc, w, l15e, qe); } \
            _Pragma("unroll") for (int m = 0; m < 9; ++m) { acc[m][0] = (f32x4){0.f, 0.f, 0.f, 0.f}; acc[m][1] = (f32x4){0.f, 0.f, 0.f, 0.f}; } \
            ++nt; } \
        __syncthreads(); }
    {
        { M_ADDR_A(); M_LA(0, 0); M_LA(0, 1); M_LA(0, 2); M_LA(0, 3); M_LA(0, 4); }
        { M_ADDR_A(); M_LA(1, 0); M_LA(1, 1); M_LA(1, 2); M_LA(1, 3); M_LA(1, 4); }
        { M_ADDR_B(); M_LB(0, 0); M_LB(0, 1); M_LB(0, 2); M_LB(0, 3); M_LB(0, 4); M_LB(0, 5); M_LB(0, 6); M_LB(0, 7); }
        M_SA(0, 0, 0); M_SA(0, 0, 1); M_SA(0, 0, 2); M_SA(0, 0, 3); M_SA(0, 0, 4);
        __syncthreads();
    }
    int s = 0;
    for (; s + 1 < total; s += 2) { M_STEP(0) M_STEP(1) }
    if (s < total) M_STEP(0)
#undef M_ADDR_A
#undef M_ADDR_B
#undef M_LA
#undef M_SA
#undef M_LB
#undef M_PIECE
#undef M_STEP
}

struct Params { const void* in[34]; float* out; unsigned char* ws; };
enum { I_X = 0, I_P, I_POS, I_GMIX, I_WIN, I_GQ, I_WQUP, I_GKV, I_WKVUP, I_ARE, I_AIM, I_BRE, I_BIM, I_CRE, I_CIM, I_SD, I_LOGSTEP, I_WGLU, I_BGLU,
       I_GATT, I_GSSM, I_WOUT, I_GMOE, I_WGR, I_BGR, I_WER, I_BER, I_WEG, I_WEU, I_WED, I_GPLE, I_WPG, I_WPP, I_GFIN };

struct KoffId { __device__ __forceinline__ int operator()(int, int k0) const { return k0; } };
struct PermAll { __device__ __forceinline__ bool operator()(int) const { return true; } };
struct PermNone { __device__ __forceinline__ bool operator()(int) const { return false; } };
template <class ColPtr, class LdF, class Scale, class Perm, class Koff = KoffId>
__device__ __forceinline__ void cvt_T(ldsp lds, int K, int Nout, bf16* out, ColPtr colptr, LdF ldf, Scale scale, Perm permf, int gwave, int nwaves, int lane, int wid, int rot = 0, Koff koff = KoffId()) {
    const ldsp t = lds + wid * 8704;
    const int ktiles = K >> 6, ntiles = Nout >> 6;
    int g0 = gwave - rot; if (g0 < 0) g0 += nwaves;
    for (int tl = g0; tl < ntiles * ktiles; tl += nwaves) {
        const int nt_ = tl % ntiles, k0 = (tl / ntiles) * 64;
        const float* src = colptr(nt_ * 64 + lane, k0); size_t ld = (size_t)ldf(nt_ * 64 + lane, k0);
        const float zm = src ? 1.f : 0.f;
        if (!src) { src = colptr(0, 0); ld = 0; }
        src += (size_t)koff(nt_ * 64 + lane, k0) * ld;
        float vv[64];
#pragma unroll
        for (int kk = 0; kk < 64; ++kk) vv[kk] = src[(size_t)kk * ld];
#pragma unroll
        for (int kk = 0; kk < 64; kk += 2)
            *(LAS unsigned*)(t + lane * 136 + kk * 2) = cvtpk(vv[kk] * (scale(k0 + kk) * zm), vv[kk + 1] * (scale(k0 + kk + 1) * zm));
#pragma unroll
        for (int i = 0; i < 8; ++i) { const int nbl = i >> 1, pp = lane & 15, c = (i & 1) * 4 + (lane >> 4);
            const int row = permf(nt_ * 2 + (nbl >> 1)) ? (nbl >> 1) * 32 + 8 * (pp >> 2) + 4 * (nbl & 1) + (pp & 3) : nbl * 16 + pp;
            const u32x2 a = *(const LAS u32x2*)(t + row * 136 + c * 16), b = *(const LAS u32x2*)(t + row * 136 + c * 16 + 8);
            *(u32x4*)(out + (((size_t)(nt_ * 4 + (i >> 1)) * (K >> 5) + (k0 >> 5) + (i & 1)) << 9) + lane * 8) = (u32x4){a.x, a.y, b.x, b.y}; }
    }
}

constexpr int AT_KP = 208, AT_VP = 136;
constexpr int AT_K0 = 0, AT_V0 = 26624;
__device__ __forceinline__ int crow(int r, int hi) { return (r & 3) + 8 * (r >> 2) + 4 * hi; }
__device__ __forceinline__ float max3f(float a, float b, float c) { float r; asm("v_max3_f32 %0, %1, %2, %3" : "=v"(r) : "v"(a), "v"(b), "v"(c)); return r; }

__device__ __forceinline__ void attn_unit(ldsp lds, int b, int h, int qb, const bf16* __restrict__ Q, const bf16* __restrict__ Kg, const bf16* __restrict__ Vt, bf16* MIX, float* ATTSS) {
    int tid = threadIdx.x; asm volatile("" : "+v"(tid));
    const int lane = tid & 63, wid = __builtin_amdgcn_readfirstlane(tid >> 6), r32 = lane & 31, hh = lane >> 5;
    const size_t bh = (size_t)b * NH + h;
    const bf16* Qb = Q + bh * SEQ * 96;
    const bf16* Kb = Kg + bh * SEQ * 96;
    const bf16* Vb = Vt + bh * 64 * SEQ;
#if NAIVE_ATTN
    if (tid < 256) {
        const int qi = qb * 256 + tid;
        float qv[96];
#pragma unroll
        for (int d = 0; d < 96; ++d) qv[d] = bf2f(Qb[(size_t)qi * 96 + d]);
        float m = -1e30f, l = 0.f, o[64];
#pragma unroll
        for (int d = 0; d < 64; ++d) o[d] = 0.f;
        for (int kv = 0; kv <= qi; ++kv) {
            float s = 0.f;
#pragma unroll
            for (int d = 0; d < 96; ++d) s += qv[d] * bf2f(Kb[(size_t)kv * 96 + d]);
            const float mn = fmaxf(m, s), al = exp2f(m - mn), p = exp2f(s - mn);
            l = l * al + p; m = mn;
#pragma unroll
            for (int d = 0; d < 64; ++d) o[d] = o[d] * al + p * bf2f(Vb[(size_t)d * SEQ + kv]);
        }
        const float inv = 1.f / l;
        bf16* dst = MIX + ((size_t)b * SEQ + qi) * 1024 + h * 64;
#pragma unroll
        float ssq = 0.f;
#pragma unroll
        for (int d = 0; d < 64; d += 2) { const unsigned wv = cvtpk(o[d] * inv, o[d + 1] * inv); *(unsigned*)(dst + d) = wv; ssq += bflo(wv) * bflo(wv) + bfhi(wv) * bfhi(wv); }
        ATTSS[(size_t)h * T + (size_t)b * SEQ + qi] = ssq;
    }
    __syncthreads();
#else
    const int qrow = qb * 256 + wid * 32 + r32;
    bf16x8 qf[6];
#pragma unroll
    for (int s = 0; s < 6; ++s) qf[s] = *(const bf16x8*)(Qb + (size_t)qrow * 96 + 16 * s + 8 * hh);
    const int nt = 4 * (qb + 1);
    f32x16 o0, o1;
#pragma unroll
    for (int r = 0; r < 16; ++r) { o0[r] = 0.f; o1[r] = 0.f; }
    float m = 0.f, l = 0.f;
    f32x16 negm;
#pragma unroll
    for (int r = 0; r < 16; ++r) negm[r] = 0.f;
    u32x4 kr0, kr1, vr;
    const int k0row = tid / 12, k0c = tid % 12, k1row = (tid + 512) / 12, k1c = (tid + 512) % 12;
    const int vd = tid >> 3, vc = tid & 7;
#define AT_LOAD(t) do { const bf16* kt_ = Kb + (size_t)(t) * 64 * 96; kr0 = *(const u32x4*)(kt_ + k0row * 96 + k0c * 8); if (tid < 256) kr1 = *(const u32x4*)(kt_ + k1row * 96 + k1c * 8); \
        vr = *(const u32x4*)(Vb + (size_t)vd * SEQ + (t) * 64 + vc * 8); } while (0)
#define AT_STORE(kst, vst) do { const ldsp kb_ = lds + AT_K0 + (kst) * 13312, vb_ = lds + AT_V0 + (vst) * 8704; *(LAS u32x4*)(kb_ + k0row * AT_KP + k0c * 16) = kr0; \
        if (tid < 256) *(LAS u32x4*)(kb_ + k1row * AT_KP + k1c * 16) = kr1; \
        *(LAS u32x2*)(vb_ + vd * AT_VP + vc * 16) = (u32x2){vr.x, vr.y}; *(LAS u32x2*)(vb_ + vd * AT_VP + vc * 16 + 8) = (u32x2){vr.z, vr.w}; } while (0)
#define AT_PV(vs_) do { const ldsp vb = lds + AT_V0 + (vs_) * 8704 + r32 * AT_VP + hh * 8; \
        _Pragma("unroll") for (int s = 0; s < 4; ++s) { \
            const u32x2 a0 = *(const LAS u32x2*)(vb + s * 32), a1 = *(const LAS u32x2*)(vb + s * 32 + 16); \
            const u32x2 c0 = *(const LAS u32x2*)(vb + 32 * AT_VP + s * 32), c1 = *(const LAS u32x2*)(vb + 32 * AT_VP + s * 32 + 16); \
            const u32x4 v0 = (u32x4){a0.x, a0.y, a1.x, a1.y}, v1 = (u32x4){c0.x, c0.y, c1.x, c1.y}; \
            o0 = __builtin_amdgcn_mfma_f32_32x32x16_bf16(__builtin_bit_cast(bf16x8, v0), __builtin_bit_cast(bf16x8, pk[s]), o0, 0, 0, 0); \
            o1 = __builtin_amdgcn_mfma_f32_32x32x16_bf16(__builtin_bit_cast(bf16x8, v1), __builtin_bit_cast(bf16x8, pk[s]), o1, 0, 0, 0); } } while (0)
    const bool lag = wid >= 4;
    bool havepk = false;
    u32x4 pk[4];
    AT_LOAD(0); AT_STORE(0, 0); __syncthreads();
    int vs = 0, vsp = 2;
    for (int t = 0; t < nt; ++t) {
        const bool more = (t + 1 < nt);
        if (more) AT_LOAD(t + 1);
        if (lag && havepk) { AT_PV(vsp); havepk = false; }
        if (t * 64 <= qb * 256 + wid * 32 + 31) {
        const ldsp kb = lds + AT_K0 + (t & 1) * 13312 + r32 * AT_KP + hh * 16;
        f32x16 s0, s1;
        {
            const bf16x8 k0f = *(const LAS bf16x8*)(kb), k1f = *(const LAS bf16x8*)(kb + 32 * AT_KP);
            s0 = __builtin_amdgcn_mfma_f32_32x32x16_bf16(k0f, qf[0], negm, 0, 0, 0);
            s1 = __builtin_amdgcn_mfma_f32_32x32x16_bf16(k1f, qf[0], negm, 0, 0, 0);
        }
#pragma unroll
        for (int s = 1; s < 6; ++s) {
            const bf16x8 k0f = *(const LAS bf16x8*)(kb + s * 32), k1f = *(const LAS bf16x8*)(kb + 32 * AT_KP + s * 32);
            s0 = __builtin_amdgcn_mfma_f32_32x32x16_bf16(k0f, qf[s], s0, 0, 0, 0);
            s1 = __builtin_amdgcn_mfma_f32_32x32x16_bf16(k1f, qf[s], s1, 0, 0, 0);
        }
        if (t >= nt - 4) {
            const int kv0 = t * 64;
#pragma unroll
            for (int r = 0; r < 16; ++r) { const int kv = kv0 + crow(r, hh); if (kv > qrow) s0[r] = -3.0e38f; if (kv + 32 > qrow) s1[r] = -3.0e38f; }
        }
        float mxa = max3f(s0[0], s0[1], s0[2]), mxb = max3f(s1[0], s1[1], s1[2]);
        mxa = max3f(mxa, s0[3], s0[4]); mxb = max3f(mxb, s1[3], s1[4]); mxa = max3f(mxa, s0[5], s0[6]); mxb = max3f(mxb, s1[5], s1[6]);
        mxa = max3f(mxa, s0[7], s0[8]); mxb = max3f(mxb, s1[7], s1[8]); mxa = max3f(mxa, s0[9], s0[10]); mxb = max3f(mxb, s1[9], s1[10]);
        mxa = max3f(mxa, s0[11], s0[12]); mxb = max3f(mxb, s1[11], s1[12]); mxa = max3f(mxa, s0[13], s0[14]); mxb = max3f(mxb, s1[13], s1[14]);
        float mx = max3f(mxa, mxb, fmaxf(s0[15], s1[15]));
        mx = fmaxf(mx, __shfl_xor(mx, 32));
        if (t == 0 || __any(mx > 8.0f)) {
            const float d = (t == 0) ? mx : fmaxf(mx, 0.f), al = __builtin_amdgcn_exp2f(-d);
            m += d; l *= al;
#pragma unroll
            for (int r = 0; r < 16; ++r) { o0[r] *= al; o1[r] *= al; s0[r] -= d; s1[r] -= d; negm[r] = -m; }
        }
        float ls = 0.f;
#pragma unroll
        for (int r = 0; r < 16; ++r) { s0[r] = __builtin_amdgcn_exp2f(s0[r]); s1[r] = __builtin_amdgcn_exp2f(s1[r]); ls += s0[r] + s1[r]; }
        l += ls;
        pk[0] = (u32x4){cvtpk(s0[0], s0[1]), cvtpk(s0[2], s0[3]), cvtpk(s0[4], s0[5]), cvtpk(s0[6], s0[7])};
        pk[1] = (u32x4){cvtpk(s0[8], s0[9]), cvtpk(s0[10], s0[11]), cvtpk(s0[12], s0[13]), cvtpk(s0[14], s0[15])};
        pk[2] = (u32x4){cvtpk(s1[0], s1[1]), cvtpk(s1[2], s1[3]), cvtpk(s1[4], s1[5]), cvtpk(s1[6], s1[7])};
        pk[3] = (u32x4){cvtpk(s1[8], s1[9]), cvtpk(s1[10], s1[11]), cvtpk(s1[12], s1[13]), cvtpk(s1[14], s1[15])};
        havepk = true;
        if (!lag) { AT_PV(vs); havepk = false; }
        }
        vsp = vs; vs = (vs == 2) ? 0 : vs + 1;
        if (more) AT_STORE((t + 1) & 1, vs);
        __syncthreads();
    }
    if (havepk) AT_PV(vsp);
#undef AT_LOAD
#undef AT_STORE
#undef AT_PV
    l += __shfl_xor(l, 32);
    const float inv = 1.f / l;
    bf16* dst = MIX + ((size_t)b * SEQ + qrow) * 1024 + h * 64 + 4 * hh;
    float ssq = 0.f;
#pragma unroll
    for (int g4 = 0; g4 < 4; ++g4) {
        const u32x2 w0 = (u32x2){cvtpk(o0[4 * g4] * inv, o0[4 * g4 + 1] * inv), cvtpk(o0[4 * g4 + 2] * inv, o0[4 * g4 + 3] * inv)};
        const u32x2 w1 = (u32x2){cvtpk(o1[4 * g4] * inv, o1[4 * g4 + 1] * inv), cvtpk(o1[4 * g4 + 2] * inv, o1[4 * g4 + 3] * inv)};
        *(u32x2*)(dst + 8 * g4) = w0; *(u32x2*)(dst + 32 + 8 * g4) = w1;
        ssq += bflo(w0.x) * bflo(w0.x) + bfhi(w0.x) * bfhi(w0.x) + bflo(w0.y) * bflo(w0.y) + bfhi(w0.y) * bfhi(w0.y) + bflo(w1.x) * bflo(w1.x) + bfhi(w1.x) * bfhi(w1.x) + bflo(w1.y) * bflo(w1.y) + bfhi(w1.y) * bfhi(w1.y);
    }
    ssq += __shfl_xor(ssq, 32);
    if (hh == 0) ATTSS[(size_t)h * T + (size_t)b * SEQ + qrow] = ssq;
    __syncthreads();
#endif
}

__global__ void __launch_bounds__(512, 2) mk_fwd(Params P) {
    extern __shared__ __attribute__((aligned(16))) unsigned char lds_raw[];
    const ldsp lds = (ldsp)lds_raw;
    const int G = gridDim.x, wg = blockIdx.x;
    const int vwg = (G % 8 == 0) ? (wg & 7) * (G >> 3) + (wg >> 3) : wg;
#define PHASE_IDS() int tid = threadIdx.x; asm volatile("" : "+v"(tid)); const int lane = tid & 63, wid = __builtin_amdgcn_readfirstlane(tid >> 6); (void)lane; (void)wid
    unsigned char* ws = P.ws;
    unsigned* ctl = (unsigned*)(ws + WS_CTL);
    LAS float* const sF = (LAS float*)(lds + M_F);
#define SF(i) (sF + 128 * (i))
    if (threadIdx.x < 2) ((LAS unsigned*)(lds + M_BARST))[threadIdx.x] = 0u;
    __syncthreads();
    XcdBarrier bar = xcd_barrier_post(ctl + CW_BAR, (volatile LAS unsigned*)(lds + M_BARST));
#define GRID_SYNC() xcd_barrier(bar)

    bf16* HB = (bf16*)(ws + WS_HB); bf16* HB2 = (bf16*)(ws + WS_HB2);
    bf16* Qg = (bf16*)(ws + WS_Q); bf16* Kg = (bf16*)(ws + WS_K); bf16* Vt = (bf16*)(ws + WS_VT); unsigned char* YB8 = ws + WS_YBUF;
    bf16* MIX = (bf16*)(ws + WS_MIX); bf16* U2 = (bf16*)(ws + WS_U2); bf16* YG = (bf16*)(ws + WS_YG);
    bf16* SCR = (bf16*)(ws + WS_SCR + (size_t)wg * SCR_PER_WG);
    float* CS = (float*)(ws + WS_CS); int* LIST = (int*)(ws + WS_LIST); float* SLOTW = (float*)(ws + WS_SLOTW);
    float* RINVM = (float*)(ws + WS_RINVM); float* ROWSS = (float*)(ws + WS_ROWSS); float* LAM16 = (float*)(ws + WS_LAM16); float* ATTSS = (float*)(ws + WS_ATTSS);

#if PH_MASK & 1
    for (int rep_ = 0; rep_ < REP_P0; ++rep_) {
        PHASE_IDS();
        const int gtid = wg * 512 + tid, gstride = G * 512;
        const int gwave = wg * 8 + wid, nwaves = G * 8;
        __syncthreads();
        { const int L = 0;
            unsigned char* wl = ws + WS_W + (size_t)L * LAYER_W;
            const float* gmix = (const float*)P.in[I_GMIX] + L * 1024; const float* win = (const float*)P.in[I_WIN] + (size_t)L * 1024 * 928;
            cvt_T(lds, 1024, 1024, (bf16*)(wl + OW_W1), [&](int n, int) -> const float* { if (n < 416) return win + n; if (n < 512) return nullptr; return win + 416 + (n - 512); }, [&](int, int) { return 928; },
                  [&](int k) { return gmix[k]; }, [&](int G32) { return G32 != 12; }, gwave, nwaves, lane, wid, 0);
            const float* gq = (const float*)P.in[I_GQ] + L * 256; const float* wq = (const float*)P.in[I_WQUP] + (size_t)L * 256 * 768;
            cvt_T(lds, 256, 768, (bf16*)(wl + OW_QN), [&](int n, int) -> const float* { return wq + n; }, [&](int, int) { return 768; }, [&](int k) { return gq[k]; }, [&](int G32) { return (G32 % 3) != 2; }, gwave, nwaves, lane, wid, 256);
            const float* gkv = (const float*)P.in[I_GKV] + L * 128; const float* wkv = (const float*)P.in[I_WKVUP] + (size_t)L * 128 * 1024;
            cvt_T(lds, 128, 512, (bf16*)(wl + OW_KN), [&](int n, int) -> const float* { return wkv + (n >> 6) * 128 + (n & 63); }, [&](int, int) { return 1024; }, [&](int k) { return gkv[k]; }, PermAll(), gwave, nwaves, lane, wid, 304);
            cvt_T(lds, 128, 512, (bf16*)(wl + OW_VV), [&](int n, int) -> const float* { return wkv + (n >> 6) * 128 + 64 + (n & 63); }, [&](int, int) { return 1024; }, [&](int k) { return gkv[k]; }, PermNone(), gwave, nwaves, lane, wid, 320);
            const float* wglu = (const float*)P.in[I_WGLU] + (size_t)L * 512 * 512;
            cvt_T(lds, 512, 512, (bf16*)(wl + OW_GLU), [&](int n, int) -> const float* { return wglu + n; }, [&](int, int) { return 512; }, [&](int) { return 1.f; }, PermAll(), gwave, nwaves, lane, wid, 336);
            const float* gmoe = (const float*)P.in[I_GMOE] + L * 1024; const float* wgr = (const float*)P.in[I_WGR] + (size_t)L * 1024 * 4; const float* wer = (const float*)P.in[I_WER] + (size_t)L * 1024 * 32;
            cvt_T(lds, 1024, 64, (bf16*)(wl + OW_WR), [&](int n, int) -> const float* { return n < 4 ? wgr + n : (n < 36 ? wer + (n - 4) : nullptr); }, [&](int n, int) { return n < 4 ? 4 : 32; },
                  [&](int k) { return gmoe[k]; }, PermNone(), gwave, nwaves, lane, wid, 400);
            const float* gat = (const float*)P.in[I_GATT] + L * 512; const float* gss = (const float*)P.in[I_GSSM] + L * 512; const float* wout = (const float*)P.in[I_WOUT] + (size_t)L * 1024 * 1024;
            cvt_T(lds, 1024, 1024, (bf16*)(wl + OW_OUT), [&](int n, int) -> const float* { return wout + n; }, [&](int, int) { return 1024; }, [&](int k) { return k < 512 ? gat[k] : gss[k - 512]; }, PermAll(), gwave, nwaves, lane, wid, 416);
            const float* gple = (const float*)P.in[I_GPLE] + L * 1024; const float* wpg = (const float*)P.in[I_WPG] + (size_t)L * 1024 * 1024; const float* wpp = (const float*)P.in[I_WPP] + (size_t)L * 256 * 1024;
            cvt_T(lds, 1280, 1024, (bf16*)(wl + OW_PGC), [&](int n, int k0) -> const float* { return (k0 < 256 ? wpp : wpg) + n; }, [&](int, int) { return 1024; },
                  [&](int k) { return k < 256 ? 1.f : gple[k - 256]; }, PermAll(), gwave, nwaves, lane, wid, 672, [&](int, int k0) { return k0 < 256 ? k0 : k0 - 256; });
        }
        {
            const int* pos = (const int*)P.in[I_POS];
            for (int idx = gtid; idx < T * 16; idx += gstride) {
                const int t = idx >> 4, i = idx & 15;
                const float inv = exp2f(-(float)i * (13.287712379549449f / 16.0f));
                float sn, cs; sincosf((float)pos[t] * inv, &sn, &cs);
                CS[(size_t)t * 32 + i] = cs; CS[(size_t)t * 32 + 16 + i] = sn;
            }
        }
        {
            const float* x = (const float*)P.in[I_X];
            for (int row0 = gwave * 4; row0 < T; row0 += nwaves * 4) {
                f32x4 v[4][4];
#pragma unroll
                for (int rr = 0; rr < 4; ++rr)
#pragma unroll
                    for (int j = 0; j < 4; ++j) v[rr][j] = ((const f32x4*)(x + (size_t)(row0 + rr) * 1024) + lane)[64 * j];
#pragma unroll
                for (int rr = 0; rr < 4; ++rr) { float sacc = 0.f;
#pragma unroll
                    for (int j = 0; j < 4; ++j) { const f32x4 w4 = v[rr][j]; sacc += w4[0] * w4[0] + w4[1] * w4[1] + w4[2] * w4[2] + w4[3] * w4[3];
                        *(u32x2*)(HB + (size_t)(row0 + rr) * 1024 + 256 * j + 4 * lane) = pack4(w4); }
#pragma unroll
                    for (int o = 1; o < 64; o <<= 1) sacc += __shfl_xor(sacc, o);
                    if (lane == 0) ROWSS[row0 + rr] = sacc; }
            }
        }
        for (int it = wg; it < DEPTH * 32 * 4; it += G) {
            const int u = it >> 2, part = it & 3, L = u >> 5, g = u & 31;
            unsigned char* wl = ws + WS_W + (size_t)L * LAYER_W;
            float* S5T = (float*)(ws + WS_S5T + (size_t)u * 40 * KiB);
            LAS float* pwr = (LAS float*)(lds + 0);
            LAS float* pwi = pwr + 17 * 64;
            LAS float* bpr = pwi + 17 * 64;
            LAS float* bpi = bpr + 1024;
            LAS float* ccr = bpi + 1024;
            LAS float* cci = ccr + 1024;
            __syncthreads();
            const float delta = __expf(((const float*)P.in[I_LOGSTEP])[L * 32 + g]);
            for (int e = tid; e < 17 * 64; e += 512) {
                const int k = e >> 6, p = e & 63;
                const float are = ((const float*)P.in[I_ARE])[(L * 32 + g) * 64 + p], aim = ((const float*)P.in[I_AIM])[(L * 32 + g) * 64 + p];
                const float mag = __expf(are * delta * (float)k); float sn, cs; sincosf(aim * delta * (float)k, &sn, &cs);
                pwr[e] = mag * cs; pwi[e] = mag * sn;
                if (part == 0) { S5T[4096 + e] = mag * cs; S5T[4096 + 1088 + e] = mag * sn;
                    if (k == 16) { LAM16[((size_t)(L * 32 + g) * 64 + p) * 2] = mag * cs; LAM16[((size_t)(L * 32 + g) * 64 + p) * 2 + 1] = mag * sn; } }
            }
            __syncthreads();
            for (int e = tid; e < 1024; e += 512) {
                const int p = e >> 4, hq = e & 15;
                const float are = ((const float*)P.in[I_ARE])[(L * 32 + g) * 64 + p], aim = ((const float*)P.in[I_AIM])[(L * 32 + g) * 64 + p];
                const float nr = pwr[64 + p] - 1.0f, ni = pwi[64 + p], den = are * are + aim * aim;
                const float fr = (nr * are + ni * aim) / den, fi = (ni * are - nr * aim) / den;
                const float br = ((const float*)P.in[I_BRE])[((size_t)(L * 32 + g) * 64 + p) * 16 + hq], bi = ((const float*)P.in[I_BIM])[((size_t)(L * 32 + g) * 64 + p) * 16 + hq];
                bpr[e] = fr * br - fi * bi; bpi[e] = fr * bi + fi * br;
                const int h2 = e >> 6, p2 = e & 63;
                const float c1 = ((const float*)P.in[I_CRE])[((size_t)(L * 32 + g) * 16 + h2) * 64 + p2], c2 = ((const float*)P.in[I_CIM])[((size_t)(L * 32 + g) * 16 + h2) * 64 + p2];
                ccr[e] = c1; cci[e] = c2;
                if (part == 0) { S5T[4096 + 2176 + e] = c1; S5T[4096 + 2176 + 1024 + e] = c2; }
            }
            __syncthreads();
            for (int e = part * 1024 + tid; e < part * 1024 + 1024; e += 512) {
                const int tau = e >> 8, hq = (e >> 4) & 15, hp = e & 15; float sacc = 0.f;
                for (int p = 0; p < 64; ++p) { const float wr = ccr[hq * 64 + p] * pwr[tau * 64 + p] - cci[hq * 64 + p] * pwi[tau * 64 + p], wi = ccr[hq * 64 + p] * pwi[tau * 64 + p] + cci[hq * 64 + p] * pwr[tau * 64 + p];
                    sacc += wr * bpr[p * 16 + hp] - wi * bpi[p * 16 + hp]; }
                S5T[e] = sacc;
            }
            bf16* Win = (bf16*)(wl + OW_SIN) + (size_t)g * 128 * 256;
            for (int e = part * 1024 + tid; e < part * 1024 + 1024; e += 512) {
                const int n = e >> 5, kc = e & 31, p = n & 63, sidx = kc >> 1, h0 = (kc & 1) * 8; float v[8];
#pragma unroll
                for (int j = 0; j < 8; ++j) { const float lr = pwr[(15 - sidx) * 64 + p], li = pwi[(15 - sidx) * 64 + p], br = bpr[p * 16 + h0 + j], bi = bpi[p * 16 + h0 + j];
                    v[j] = (n < 64) ? (lr * br - li * bi) : (lr * bi + li * br); }
                *(u32x4*)(Win + fm_off(n, kc * 8, 256)) = (u32x4){cvtpk(v[0], v[1]), cvtpk(v[2], v[3]), cvtpk(v[4], v[5]), cvtpk(v[6], v[7])};
            }
            __syncthreads();
        }
    }
#endif
    GRID_SYNC();

    for (int L = 0; L < DEPTH; ++L) {
        unsigned char* wl = ws + WS_W + (size_t)L * LAYER_W;
        const bf16 *W1 = (const bf16*)(wl + OW_W1), *WQN = (const bf16*)(wl + OW_QN), *WKN = (const bf16*)(wl + OW_KN), *WVV = (const bf16*)(wl + OW_VV),
                   *WGLU = (const bf16*)(wl + OW_GLU), *WR = (const bf16*)(wl + OW_WR), *WOUT = (const bf16*)(wl + OW_OUT), *WPGC = (const bf16*)(wl + OW_PGC),
                   *WSIN = (const bf16*)(wl + OW_SIN), *WSTW = (const bf16*)(wl + OW_STW), *WGU = (const bf16*)(wl + OW_GU), *WDN = (const bf16*)(wl + OW_DN);

        if (L == 0) {
            PHASE_IDS();
            for (int it = wg; it < DEPTH * 32 * 4; it += G) {
                const int u = it >> 2, part = it & 3, L2 = u >> 5, g = u & 31;
                const float* S5T = (const float*)(ws + WS_S5T + (size_t)u * 40 * KiB);
                LAS float* tb = (LAS float*)(lds + 0);
                __syncthreads();
                for (int e = tid; e < 4096 + 2176 + 2048; e += 512) tb[e] = S5T[e];
                __syncthreads();
                const LAS float* ktab = tb; const LAS float* pwr = tb + 4096; const LAS float* pwi = pwr + 1088; const LAS float* ccr = pwi + 1088; const LAS float* cci = ccr + 1024;
                bf16* TW = (bf16*)(ws + WS_W + (size_t)L2 * LAYER_W + OW_STW) + (size_t)g * 256 * 384;
                const float* sd = (const float*)P.in[I_SD] + (L2 * 32 + g) * 16;
                for (int e = part * 64 * 48 + tid; e < (part + 1) * 64 * 48; e += 512) {
                    const int n = e / 48, kc = e % 48, i = n >> 4, hq = n & 15; float v[8];
                    if (kc < 32) { const int sidx = kc >> 1, h0 = (kc & 1) * 8;
#pragma unroll
                        for (int j = 0; j < 8; ++j) { float x = (i >= sidx) ? ktab[((i - sidx) * 16 + hq) * 16 + h0 + j] : 0.f; if (i == sidx && hq == h0 + j) x += sd[hq]; v[j] = x; }
                    } else { const int p0 = (kc - 32) * 8;
#pragma unroll
                        for (int j = 0; j < 8; ++j) { const int p2 = p0 + j, p = p2 & 63; const float cr = ccr[hq * 64 + p], ci = cci[hq * 64 + p], lr = pwr[(i + 1) * 64 + p], li = pwi[(i + 1) * 64 + p];
                            v[j] = (p2 < 64) ? (cr * lr - ci * li) : -(cr * li + ci * lr); }
                    }
                    *(u32x4*)(TW + fm_off_p(n, kc * 8, 384)) = (u32x4){cvtpk(v[0], v[1]), cvtpk(v[2], v[3]), cvtpk(v[4], v[5]), cvtpk(v[6], v[7])};
                }
            }
            __syncthreads();
        }
#if PH_MASK & 2
        for (int rep_ = 0; rep_ < REP_P1; ++rep_)
        for (int tile = wg; tile < NTILE; tile += G) {
            PHASE_IDS();
            const int R0 = tile * 128;
            bf16* QLAT = SCR;
            bf16* KVLAT = SCR + 128 * 256;
            __syncthreads();
            if (tid < 128) { SF(0)[tid] = rsqrtf(ROWSS[R0 + tid] * (1.f / 1024.f) + EPS); }
            __syncthreads();
            bool xl_ok = (L == 0);
            gemm_rows<2, true>(lds, ALPlain{HB + (size_t)R0 * 1024, 1024}, W1, 1024, 4, 8, [&](int nt, f32x4 (&acc)[8][2], int w, int l15, int q) {
                if (!xl_ok) { unsigned* xl_ = ctl + CW_XL; XB_SPIN(xb_ld(xl_) < (unsigned)(G * L), ctl + CW_BAR); xl_ok = true; }
#pragma unroll
                for (int mf = 0; mf < 8; ++mf) {
                    const int row = mf * 16 + l15, tok = R0 + row; const float rv = SF(0)[row];
                    const int b = tok >> 11, t = tok & 2047;
                    if (nt == 0) {
                        const f32x4 v0 = acc[mf][0] * rv, v1 = acc[mf][1] * rv;
                        float ss = (v0[0] * v0[0] + v0[1] * v0[1] + v0[2] * v0[2] + v0[3] * v0[3]) + (v1[0] * v1[0] + v1[1] * v1[1] + v1[2] * v1[2] + v1[3] * v1[3]);
                        *(LAS u32x4*)(lds + LDS_B0 + (w >> 2) * 32768 + row * 256 + ((((w & 3) * 4 + q) ^ l15) << 4)) = pack8(v0, v1);
                        ss += __shfl_xor(ss, 16); ss += __shfl_xor(ss, 32);
                        if (q == 0) SF(8 + w)[row] = ss;
                    } else if (nt == 1) {
                        if (w < 4) {
                            const f32x4 v0 = acc[mf][0] * rv, v1 = acc[mf][1] * rv;
                            float ss = (v0[0] * v0[0] + v0[1] * v0[1] + v0[2] * v0[2] + v0[3] * v0[3]) + (v1[0] * v1[0] + v1[1] * v1[1] + v1[2] * v1[2] + v1[3] * v1[3]);
                            *(u32x4*)(KVLAT + row * 128 + w * 32 + 8 * q) = pack8(v0, v1);
                            ss += __shfl_xor(ss, 16); ss += __shfl_xor(ss, 32);
                            if (q == 0) SF(16 + w)[row] = ss;
                        } else if (w == 4) {
                            const f32x4 x1 = acc[mf][0] * rv, x2 = acc[mf][1] * rv;
                            const f32x4 c = *(const f32x4*)(CS + (size_t)tok * 32 + 4 * q), sn = *(const f32x4*)(CS + (size_t)tok * 32 + 16 + 4 * q);
                            const u32x2 o1 = pack4(x1 * c - x2 * sn), o2 = pack4(x1 * sn + x2 * c);
#pragma unroll
                            for (int h = 0; h < NH; ++h) { bf16* kp = Kg + (((size_t)b * NH + h) * SEQ + t) * 96 + 64 + 4 * q; *(u32x2*)kp = o1; *(u32x2*)(kp + 16) = o2; }
                        }
                    } else {
                        const int c16 = t >> 4, s16 = t & 15, cu = (nt - 2) * 256 + w * 32 + 8 * q, g = cu >> 4;
                        *(u32x4*)(U2 + ((size_t)g * 2048 + b * 128 + c16) * 256 + s16 * 16 + (cu & 15)) = pack8(acc[mf][0] * rv, acc[mf][1] * rv);
                    }
                }
            });
            if (tid < 128) { SF(1)[tid] = rsqrtf((((SF(8)[tid] + SF(9)[tid]) + (SF(10)[tid] + SF(11)[tid])) + ((SF(12)[tid] + SF(13)[tid]) + (SF(14)[tid] + SF(15)[tid]))) * (1.f / 256.f) + EPS);
                             SF(2)[tid] = rsqrtf(((SF(16)[tid] + SF(17)[tid]) + (SF(18)[tid] + SF(19)[tid])) * (1.f / 128.f) + EPS); }
            __syncthreads();
            const ALPlain Aq{QLAT, 256}, Akv{KVLAT, 128};
            gemm_rows<2, true, false, true>(lds, Aq, WQN, 256, 3, 8, [&](int nt, f32x4 (&acc)[8][2], int w, int l15, int q) {
                const int ch = nt * 8 + w, h = ch / 3, part = ch - 3 * h;
#pragma unroll
                for (int mf = 0; mf < 8; ++mf) { const int row = mf * 16 + l15, tok = R0 + row, b = tok >> 11, t = tok & 2047; const float rv = SF(1)[row] * QSCALE;
                    bf16* qp = Qg + (((size_t)b * NH + h) * SEQ + t) * 96 + part * 32 + 4 * q;
                    if (part < 2) { *(u32x4*)(qp + 4 * q) = pack8(acc[mf][0] * rv, acc[mf][1] * rv); }
                    else { const f32x4 c = *(const f32x4*)(CS + (size_t)tok * 32 + 4 * q), sn = *(const f32x4*)(CS + (size_t)tok * 32 + 16 + 4 * q);
                        const f32x4 x1 = acc[mf][0] * rv, x2 = acc[mf][1] * rv; *(u32x2*)qp = pack4(x1 * c - x2 * sn); *(u32x2*)(qp + 16) = pack4(x1 * sn + x2 * c); } }
            }, true, false);
            VM_WAIT(); __syncthreads();
            gemm_rows<2, true>(lds, Akv, WKN, 128, 2, 8, [&](int nt, f32x4 (&acc)[8][2], int w, int l15, int q) {
#pragma unroll
                for (int mf = 0; mf < 8; ++mf) { const int row = mf * 16 + l15, tok = R0 + row, b = tok >> 11, t = tok & 2047; const float rv = SF(2)[row];
                    const int col = nt * 256 + w * 32 + 8 * q, h = col >> 6, d = col & 63;
                    *(u32x4*)(Kg + (((size_t)b * NH + h) * SEQ + t) * 96 + d) = pack8(acc[mf][0] * rv, acc[mf][1] * rv); }
            });
            gemm_rows<2, false>(lds, Akv, WVV, 128, 2, 8, [&](int nt, f32x4 (&acc)[8][2], int w, int l15, int q) {
#pragma unroll
                for (int mf = 0; mf < 8; ++mf) { const int row0 = mf * 16 + 4 * q, tok0 = R0 + row0, b = tok0 >> 11, t0 = tok0 & 2047;
                    const f32x4 rv = *(const LAS f32x4*)(SF(2) + row0);
#pragma unroll
                    for (int nf = 0; nf < 2; ++nf) { const int col = nt * 256 + w * 32 + nf * 16 + l15, h = col >> 6, d = col & 63;
                        *(u32x2*)(Vt + (((size_t)b * NH + h) * 64 + d) * SEQ + t0) = pack4(acc[mf][nf] * rv); } }
            });
        }
#endif
        GRID_SYNC();

        const bool cvt_first = (wg & 8) == 0;
        if (L == 0 && cvt_first) { PHASE_IDS(); const int gwave = wg * 8 + wid, nwaves = G * 8; __syncthreads();
        { const int L = 0;
            unsigned char* wl = ws + WS_W + (size_t)L * LAYER_W; const float* gmoe = (const float*)P.in[I_GMOE] + L * 1024;
            const float* weg = (const float*)P.in[I_WEG] + (size_t)L * 32 * 1024 * 256; const float* weu = (const float*)P.in[I_WEU] + (size_t)L * 32 * 1024 * 256;
            cvt_T(lds, 1024, 32 * 512, (bf16*)(wl + OW_GU), [&](int n, int) -> const float* { const int e = n >> 9, np = n & 511, blk = np >> 5, up = (np >> 4) & 1, j = np & 15;
                      return (up ? weu : weg) + (size_t)e * 1024 * 256 + blk * 16 + j; }, [&](int, int) { return 256; }, [&](int k) { return gmoe[k]; }, PermNone(), gwave, nwaves, lane, wid);
            const float* wed = (const float*)P.in[I_WED] + (size_t)L * 32 * 256 * 1024;
            cvt_T(lds, 256, 32 * 1024, (bf16*)(wl + OW_DN), [&](int n, int) -> const float* { return wed + (size_t)(n >> 10) * 256 * 1024 + (n & 1023); }, [&](int, int) { return 1024; }, [&](int) { return 1.f; }, PermAll(), gwave, nwaves, lane, wid);
        }
        { const int L = 1;
            unsigned char* wl = ws + WS_W + (size_t)L * LAYER_W;
            const float* gmix = (const float*)P.in[I_GMIX] + L * 1024; const float* win = (const float*)P.in[I_WIN] + (size_t)L * 1024 * 928;
            cvt_T(lds, 1024, 1024, (bf16*)(wl + OW_W1), [&](int n, int) -> const float* { if (n < 416) return win + n; if (n < 512) return nullptr; return win + 416 + (n - 512); }, [&](int, int) { return 928; },
                  [&](int k) { return gmix[k]; }, [&](int G32) { return G32 != 12; }, gwave, nwaves, lane, wid, 0);
            const float* gq = (const float*)P.in[I_GQ] + L * 256; const float* wq = (const float*)P.in[I_WQUP] + (size_t)L * 256 * 768;
            cvt_T(lds, 256, 768, (bf16*)(wl + OW_QN), [&](int n, int) -> const float* { return wq + n; }, [&](int, int) { return 768; }, [&](int k) { return gq[k]; }, [&](int G32) { return (G32 % 3) != 2; }, gwave, nwaves, lane, wid, 256);
            const float* gkv = (const float*)P.in[I_GKV] + L * 128; const float* wkv = (const float*)P.in[I_WKVUP] + (size_t)L * 128 * 1024;
            cvt_T(lds, 128, 512, (bf16*)(wl + OW_KN), [&](int n, int) -> const float* { return wkv + (n >> 6) * 128 + (n & 63); }, [&](int, int) { return 1024; }, [&](int k) { return gkv[k]; }, PermAll(), gwave, nwaves, lane, wid, 304);
            cvt_T(lds, 128, 512, (bf16*)(wl + OW_VV), [&](int n, int) -> const float* { return wkv + (n >> 6) * 128 + 64 + (n & 63); }, [&](int, int) { return 1024; }, [&](int k) { return gkv[k]; }, PermNone(), gwave, nwaves, lane, wid, 320);
            const float* wglu = (const float*)P.in[I_WGLU] + (size_t)L * 512 * 512;
            cvt_T(lds, 512, 512, (bf16*)(wl + OW_GLU), [&](int n, int) -> const float* { return wglu + n; }, [&](int, int) { return 512; }, [&](int) { return 1.f; }, PermAll(), gwave, nwaves, lane, wid, 336);
            const float* gmoe = (const float*)P.in[I_GMOE] + L * 1024; const float* wgr = (const float*)P.in[I_WGR] + (size_t)L * 1024 * 4; const float* wer = (const float*)P.in[I_WER] + (size_t)L * 1024 * 32;
            cvt_T(lds, 1024, 64, (bf16*)(wl + OW_WR), [&](int n, int) -> const float* { return n < 4 ? wgr + n : (n < 36 ? wer + (n - 4) : nullptr); }, [&](int n, int) { return n < 4 ? 4 : 32; },
                  [&](int k) { return gmoe[k]; }, PermNone(), gwave, nwaves, lane, wid, 400);
            const float* gat = (const float*)P.in[I_GATT] + L * 512; const float* gss = (const float*)P.in[I_GSSM] + L * 512; const float* wout = (const float*)P.in[I_WOUT] + (size_t)L * 1024 * 1024;
            cvt_T(lds, 1024, 1024, (bf16*)(wl + OW_OUT), [&](int n, int) -> const float* { return wout + n; }, [&](int, int) { return 1024; }, [&](int k) { return k < 512 ? gat[k] : gss[k - 512]; }, PermAll(), gwave, nwaves, lane, wid, 416);
            const float* gple = (const float*)P.in[I_GPLE] + L * 1024; const float* wpg = (const float*)P.in[I_WPG] + (size_t)L * 1024 * 1024; const float* wpp = (const float*)P.in[I_WPP] + (size_t)L * 256 * 1024;
            cvt_T(lds, 1280, 1024, (bf16*)(wl + OW_PGC), [&](int n, int k0) -> const float* { return (k0 < 256 ? wpp : wpg) + n; }, [&](int, int) { return 1024; },
                  [&](int k) { return k < 256 ? 1.f : gple[k - 256]; }, PermAll(), gwave, nwaves, lane, wid, 672, [&](int, int k0) { return k0 < 256 ? k0 : k0 - 256; });
        }
            __syncthreads(); }
#if PH_MASK & 4
        for (int rep_ = 0; rep_ < REP_P2S; ++rep_)
        for (int u = wg; u < 512; u += G) {
            PHASE_IDS();
            const int g = u & 31, b = u >> 5;
            const bf16* Ua = U2 + ((size_t)g * 2048 + b * 128) * 256;
            bf16* XP = SCR;
            LAS float* SLm = (LAS float*)(lds + LDS_B0);
            __syncthreads();
            gemm_rows<1, true>(lds, ALPlain{Ua, 256}, WSIN + (size_t)g * 128 * 256, 256, 1, 8, [&](int, f32x4 (&acc)[8][1], int w, int l15, int q) {
#pragma unroll
                for (int mf = 0; mf < 8; ++mf) *(LAS f32x4*)(SLm + (mf * 16 + l15) * 128 + w * 16 + 4 * q) = acc[mf][0];
            });
            __syncthreads();
            {
                const int p = tid & 63, seg = tid >> 6;
                const float l16r = LAM16[((size_t)(L * 32 + g) * 64 + p) * 2], l16i = LAM16[((size_t)(L * 32 + g) * 64 + p) * 2 + 1];
                float xr = 0.f, xi = 0.f, lr[16], li[16];
#pragma unroll
                for (int j = 0; j < 16; ++j) { lr[j] = xr; li[j] = xi; const int c = seg * 16 + j;
                    const float sr = SLm[c * 128 + p], si = SLm[c * 128 + 64 + p];
                    const float nr = l16r * xr - l16i * xi + sr, ni = l16r * xi + l16i * xr + si; xr = nr; xi = ni; }
                float pr = l16r, pi = l16i;
#pragma unroll
                for (int j = 0; j < 4; ++j) { const float tr = pr * pr - pi * pi, ti = 2.f * pr * pi; pr = tr; pi = ti; }
                LAS float* TOT = (LAS float*)(lds + 0);
                TOT[(seg * 64 + p) * 2] = xr; TOT[(seg * 64 + p) * 2 + 1] = xi;
                __syncthreads();
                float cr = 0.f, ci = 0.f;
                for (int j = 0; j < seg; ++j) { const float tr = TOT[(j * 64 + p) * 2], ti = TOT[(j * 64 + p) * 2 + 1];
                    const float nr = pr * cr - pi * ci + tr, ni = pr * ci + pi * cr + ti; cr = nr; ci = ni; }
#pragma unroll
                for (int j = 0; j < 16; ++j) { const int c = seg * 16 + j;
                    XP[c * 128 + p] = (bf16)(cvtpk(lr[j] + cr, 0.f) & 0xffffu); XP[c * 128 + 64 + p] = (bf16)(cvtpk(li[j] + ci, 0.f) & 0xffffu);
                    const float nr = l16r * cr - l16i * ci, ni = l16r * ci + l16i * cr; cr = nr; ci = ni; }
            }
            BLOCK_SEAM();
            gemm_rows<2, true>(lds, ALTwo{Ua, 256, 256, XP, 128}, WSTW + (size_t)g * 256 * 384, 384, 1, 8, [&](int, f32x4 (&acc)[8][2], int w, int l15, int q) {
#pragma unroll
                for (int mf = 0; mf < 8; ++mf) { const int row = mf * 16 + l15;
                    const int col = w * 32 + 8 * q, i = col >> 4; const size_t tok = (size_t)b * SEQ + 16 * row + i; f32x4 v0 = acc[mf][0], v1 = acc[mf][1];
#pragma unroll
                    for (int r = 0; r < 4; ++r) { v0[r] = gelu_tanh(v0[r]); v1[r] = gelu_tanh(v1[r]); }
                    *(u32x4*)(YG + tok * 512 + g * 16 + (col & 15)) = pack8(v0, v1); }
            });
        }
#endif
#if PH_MASK & 8
        for (int rep_ = 0; rep_ < REP_P2A; ++rep_)
        for (int pr = vwg; pr < 512; pr += G) {
            const int bh = pr >> 2, s = pr & 3;
            __syncthreads();
            attn_unit(lds, bh >> 3, bh & 7, s, Qg, Kg, Vt, MIX, ATTSS);
            __syncthreads();
            attn_unit(lds, bh >> 3, bh & 7, 7 - s, Qg, Kg, Vt, MIX, ATTSS);
        }
#endif
        if (L == 0 && !cvt_first) { PHASE_IDS(); const int gwave = wg * 8 + wid, nwaves = G * 8; __syncthreads();
        { const int L = 0;
            unsigned char* wl = ws + WS_W + (size_t)L * LAYER_W; const float* gmoe = (const float*)P.in[I_GMOE] + L * 1024;
            const float* weg = (const float*)P.in[I_WEG] + (size_t)L * 32 * 1024 * 256; const float* weu = (const float*)P.in[I_WEU] + (size_t)L * 32 * 1024 * 256;
            cvt_T(lds, 1024, 32 * 512, (bf16*)(wl + OW_GU), [&](int n, int) -> const float* { const int e = n >> 9, np = n & 511, blk = np >> 5, up = (np >> 4) & 1, j = np & 15;
                      return (up ? weu : weg) + (size_t)e * 1024 * 256 + blk * 16 + j; }, [&](int, int) { return 256; }, [&](int k) { return gmoe[k]; }, PermNone(), gwave, nwaves, lane, wid);
            const float* wed = (const float*)P.in[I_WED] + (size_t)L * 32 * 256 * 1024;
            cvt_T(lds, 256, 32 * 1024, (bf16*)(wl + OW_DN), [&](int n, int) -> const float* { return wed + (size_t)(n >> 10) * 256 * 1024 + (n & 1023); }, [&](int, int) { return 1024; }, [&](int) { return 1.f; }, PermAll(), gwave, nwaves, lane, wid);
        }
        { const int L = 1;
            unsigned char* wl = ws + WS_W + (size_t)L * LAYER_W;
            const float* gmix = (const float*)P.in[I_GMIX] + L * 1024; const float* win = (const float*)P.in[I_WIN] + (size_t)L * 1024 * 928;
            cvt_T(lds, 1024, 1024, (bf16*)(wl + OW_W1), [&](int n, int) -> const float* { if (n < 416) return win + n; if (n < 512) return nullptr; return win + 416 + (n - 512); }, [&](int, int) { return 928; },
                  [&](int k) { return gmix[k]; }, [&](int G32) { return G32 != 12; }, gwave, nwaves, lane, wid, 0);
            const float* gq = (const float*)P.in[I_GQ] + L * 256; const float* wq = (const float*)P.in[I_WQUP] + (size_t)L * 256 * 768;
            cvt_T(lds, 256, 768, (bf16*)(wl + OW_QN), [&](int n, int) -> const float* { return wq + n; }, [&](int, int) { return 768; }, [&](int k) { return gq[k]; }, [&](int G32) { return (G32 % 3) != 2; }, gwave, nwaves, lane, wid, 256);
            const float* gkv = (const float*)P.in[I_GKV] + L * 128; const float* wkv = (const float*)P.in[I_WKVUP] + (size_t)L * 128 * 1024;
            cvt_T(lds, 128, 512, (bf16*)(wl + OW_KN), [&](int n, int) -> const float* { return wkv + (n >> 6) * 128 + (n & 63); }, [&](int, int) { return 1024; }, [&](int k) { return gkv[k]; }, PermAll(), gwave, nwaves, lane, wid, 304);
            cvt_T(lds, 128, 512, (bf16*)(wl + OW_VV), [&](int n, int) -> const float* { return wkv + (n >> 6) * 128 + 64 + (n & 63); }, [&](int, int) { return 1024; }, [&](int k) { return gkv[k]; }, PermNone(), gwave, nwaves, lane, wid, 320);
            const float* wglu = (const float*)P.in[I_WGLU] + (size_t)L * 512 * 512;
            cvt_T(lds, 512, 512, (bf16*)(wl + OW_GLU), [&](int n, int) -> const float* { return wglu + n; }, [&](int, int) { return 512; }, [&](int) { return 1.f; }, PermAll(), gwave, nwaves, lane, wid, 336);
            const float* gmoe = (const float*)P.in[I_GMOE] + L * 1024; const float* wgr = (const float*)P.in[I_WGR] + (size_t)L * 1024 * 4; const float* wer = (const float*)P.in[I_WER] + (size_t)L * 1024 * 32;
            cvt_T(lds, 1024, 64, (bf16*)(wl + OW_WR), [&](int n, int) -> const float* { return n < 4 ? wgr + n : (n < 36 ? wer + (n - 4) : nullptr); }, [&](int n, int) { return n < 4 ? 4 : 32; },
                  [&](int k) { return gmoe[k]; }, PermNone(), gwave, nwaves, lane, wid, 400);
            const float* gat = (const float*)P.in[I_GATT] + L * 512; const float* gss = (const float*)P.in[I_GSSM] + L * 512; const float* wout = (const float*)P.in[I_WOUT] + (size_t)L * 1024 * 1024;
            cvt_T(lds, 1024, 1024, (bf16*)(wl + OW_OUT), [&](int n, int) -> const float* { return wout + n; }, [&](int, int) { return 1024; }, [&](int k) { return k < 512 ? gat[k] : gss[k - 512]; }, PermAll(), gwave, nwaves, lane, wid, 416);
            const float* gple = (const float*)P.in[I_GPLE] + L * 1024; const float* wpg = (const float*)P.in[I_WPG] + (size_t)L * 1024 * 1024; const float* wpp = (const float*)P.in[I_WPP] + (size_t)L * 256 * 1024;
            cvt_T(lds, 1280, 1024, (bf16*)(wl + OW_PGC), [&](int n, int k0) -> const float* { return (k0 < 256 ? wpp : wpg) + n; }, [&](int, int) { return 1024; },
                  [&](int k) { return k < 256 ? 1.f : gple[k - 256]; }, PermAll(), gwave, nwaves, lane, wid, 672, [&](int, int k0) { return k0 < 256 ? k0 : k0 - 256; });
        }
            __syncthreads(); }
        GRID_SYNC();

        unsigned* CNT = ctl + CW_CNT + L * 32 * 64;
#if PH_MASK & 16
        for (int tile = wg; tile < NTILE; tile += G) {
            PHASE_IDS();
            const int R0 = tile * 128;
            __syncthreads();
            for (int i = tid; i < 16 * 128; i += 512) SF(8)[i] = 0.f;
            if (tid < 32) ((LAS int*)(lds + M_CNT))[tid] = 0;
            if (tid < 128) { float ss = 0.f;
#pragma unroll
                for (int hd = 0; hd < 8; ++hd) ss += ATTSS[(size_t)hd * T + R0 + tid];
                SF(1)[tid] = rsqrtf(ss * (1.f / 512.f) + EPS); }
            __syncthreads();
            const float* bglu = (const float*)P.in[I_BGLU] + L * 512;
            gemm_rows<2, true>(lds, ALPlain{YG + (size_t)R0 * 512, 512}, WGLU, 512, 2, 8, [&](int nt, f32x4 (&acc)[8][2], int w, int l15, int q) {
#pragma unroll
                for (int mf = 0; mf < 8; ++mf) { const int row = mf * 16 + l15; const size_t tok = R0 + row; float ss = 0.f;
                    const int col = nt * 256 + w * 32 + 8 * q; const u32x4 yw = *(const u32x4*)(YG + tok * 512 + col);
                    const f32x4 y0 = unpack4((u32x2){yw.x, yw.y}), y1 = unpack4((u32x2){yw.z, yw.w}), b0 = *(const f32x4*)(bglu + col), b1 = *(const f32x4*)(bglu + col + 4); f32x4 v0, v1;
#pragma unroll
                    for (int r = 0; r < 4; ++r) { v0[r] = y0[r] * sigmoidf_(acc[mf][0][r] + b0[r]); v1[r] = y1[r] * sigmoidf_(acc[mf][1][r] + b1[r]); ss += v0[r] * v0[r] + v1[r] * v1[r]; }
                    *(u32x4*)(MIX + tok * 1024 + 512 + col) = pack8(v0, v1);
                    ss += __shfl_xor(ss, 16); ss += __shfl_xor(ss, 32);
                    if (q == 0) SF(8 + w)[row] += ss; }
            });
            BLOCK_SEAM();
            if (tid < 128) { const float rs = rsqrtf((((SF(8)[tid] + SF(9)[tid]) + (SF(10)[tid] + SF(11)[tid])) + ((SF(12)[tid] + SF(13)[tid]) + (SF(14)[tid] + SF(15)[tid]))) * (1.f / 512.f) + EPS);
                SF(2)[tid] = rs; SF(4)[tid] = SF(1)[tid] / rs; }
            __syncthreads();
            gemm_rows<2, true>(lds, ALPlain{MIX + (size_t)R0 * 1024, 1024}, WOUT, 1024, 4, 8, [&](int nt, f32x4 (&acc)[8][2], int w, int l15, int q) {
#pragma unroll
                for (int mf = 0; mf < 8; ++mf) { const int row = mf * 16 + l15; const size_t tok = R0 + row; const float rs = SF(2)[row]; float ss = 0.f;
                    bf16* hp = HB + tok * 1024 + nt * 256 + w * 32 + 8 * q; const u32x4 hw = *(const u32x4*)hp;
                    const f32x4 v0 = unpack4((u32x2){hw.x, hw.y}) + acc[mf][0] * rs, v1 = unpack4((u32x2){hw.z, hw.w}) + acc[mf][1] * rs;
                    ss += (v0[0] * v0[0] + v0[1] * v0[1] + v0[2] * v0[2] + v0[3] * v0[3]) + (v1[0] * v1[0] + v1[1] * v1[1] + v1[2] * v1[2] + v1[3] * v1[3]); *(u32x4*)hp = pack8(v0, v1);
                    ss += __shfl_xor(ss, 16); ss += __shfl_xor(ss, 32);
                    if (q == 0) SF(16 + w)[row] += ss; }
            }, true, false, 3, [&](f32x4 (&acc)[8][2], int, int l15, int) {
#pragma unroll
                for (int mf = 0; mf < 8; ++mf) { const float r = SF(4)[mf * 16 + l15]; acc[mf][0] *= r; acc[mf][1] *= r; }
            });
            BLOCK_SEAM();
            if (tid < 128) { const float rv = rsqrtf((((SF(16)[tid] + SF(17)[tid]) + (SF(18)[tid] + SF(19)[tid])) + ((SF(20)[tid] + SF(21)[tid]) + (SF(22)[tid] + SF(23)[tid]))) * (1.f / 1024.f) + EPS); SF(3)[tid] = rv; RINVM[R0 + tid] = rv; }
            __syncthreads();
            {
                const float* bgr = (const float*)P.in[I_BGR] + L * 4; const float* ber = (const float*)P.in[I_BER] + L * 32;
                LAS float* LG = (LAS float*)(lds + M_LOG);
                gemm_rows<1, true, false, false, true>(lds, ALPlain{HB + (size_t)R0 * 1024, 1024}, WR, 1024, 1, 3, [&](int, f32x4 (&acc)[8][1], int w, int l15, int q) {
#pragma unroll
                    for (int mf = 0; mf < 8; ++mf) { const int row = mf * 16 + l15; const float rv = SF(3)[row];
#pragma unroll
                        for (int r = 0; r < 4; ++r) { const int col = w * 16 + 4 * q + r; if (col < 36) LG[row * 40 + col] = acc[mf][0][r] * rv + (col < 4 ? bgr[col] : ber[col - 4]); } }
                });
                __syncthreads();
                LAS int* sEID = (LAS int*)(lds + M_EID); LAS int* sRANK = (LAS int*)(lds + M_RANK); LAS float* sW2 = (LAS float*)(lds + M_W2);
                LAS int* sCNT = (LAS int*)(lds + M_CNT); LAS int* sBASE = (LAS int*)(lds + M_BASE);
                if (tid < 128) {
                    const LAS float* lg = LG + tid * 40;
                    float gm = lg[0]; int gi = 0;
#pragma unroll
                    for (int j = 1; j < 4; ++j) if (lg[j] > gm) { gm = lg[j]; gi = j; }
                    float gs = 0.f;
#pragma unroll
                    for (int j = 0; j < 4; ++j) gs += __expf(lg[j] - gm);
                    const float gp = 1.f / gs;
                    float e1 = -3.0e38f, e2 = -3.0e38f; int i1 = 0, i2 = 0;
#pragma unroll
                    for (int j = 0; j < 8; ++j) { const float v = lg[4 + gi * 8 + j]; if (v > e1) { e2 = e1; i2 = i1; e1 = v; i1 = j; } else if (v > e2) { e2 = v; i2 = j; } }
                    const float w1 = 1.f / (1.f + __expf(e2 - e1)), w2 = 1.f - w1;
                    const int E1 = gi * 8 + i1, E2 = gi * 8 + i2;
                    sEID[2 * tid] = E1; sEID[2 * tid + 1] = E2; sW2[2 * tid] = gp * w1; sW2[2 * tid + 1] = gp * w2;
                    sRANK[2 * tid] = atomicAdd((int*)(sCNT + E1), 1); sRANK[2 * tid + 1] = atomicAdd((int*)(sCNT + E2), 1);
                }
                __syncthreads();
                if (tid < 32) sBASE[tid] = (int)__hip_atomic_fetch_add(CNT + tid * 64, (unsigned)sCNT[tid], __ATOMIC_RELAXED, __HIP_MEMORY_SCOPE_AGENT);
                __syncthreads();
                if (tid < 256) { const int e = sEID[tid], pos = sBASE[e] + sRANK[tid], slot = R0 * 2 + tid; LIST[(size_t)e * 32768 + pos] = slot; SLOTW[slot] = sW2[tid]; }
            }
        }
#endif
        GRID_SYNC();

        if (L == 0 && cvt_first) { PHASE_IDS(); const int gwave = wg * 8 + wid, nwaves = G * 8; __syncthreads();
        { const int L = 1;
            unsigned char* wl = ws + WS_W + (size_t)L * LAYER_W; const float* gmoe = (const float*)P.in[I_GMOE] + L * 1024;
            const float* weg = (const float*)P.in[I_WEG] + (size_t)L * 32 * 1024 * 256; const float* weu = (const float*)P.in[I_WEU] + (size_t)L * 32 * 1024 * 256;
            cvt_T(lds, 1024, 32 * 512, (bf16*)(wl + OW_GU), [&](int n, int) -> const float* { const int e = n >> 9, np = n & 511, blk = np >> 5, up = (np >> 4) & 1, j = np & 15;
                      return (up ? weu : weg) + (size_t)e * 1024 * 256 + blk * 16 + j; }, [&](int, int) { return 256; }, [&](int k) { return gmoe[k]; }, PermNone(), gwave, nwaves, lane, wid);
            const float* wed = (const float*)P.in[I_WED] + (size_t)L * 32 * 256 * 1024;
            cvt_T(lds, 256, 32 * 1024, (bf16*)(wl + OW_DN), [&](int n, int) -> const float* { return wed + (size_t)(n >> 10) * 256 * 1024 + (n & 1023); }, [&](int, int) { return 1024; }, [&](int) { return 1.f; }, PermAll(), gwave, nwaves, lane, wid);
        }
            __syncthreads(); }
#if PH_MASK & 32
        for (int rep_ = 0; rep_ < REP_P4; ++rep_) {
            PHASE_IDS();
            LAS int* sECNT = (LAS int*)(lds + M_ECNT); LAS int* sTOK = (LAS int*)(lds + M_TOK); LAS int* sSLOT = (LAS int*)(lds + M_SLOT);
            LAS float* sWT = (LAS float*)(lds + M_WT); LAS float* sRV = (LAS float*)(lds + M_RV);
            __syncthreads();
            if (tid < 32) sECNT[tid] = (int)__hip_atomic_load(CNT + tid * 64, __ATOMIC_RELAXED, __HIP_MEMORY_SCOPE_AGENT);
            __syncthreads();
            int ctiles = 0;
            for (int e = 0; e < 32; ++e) ctiles += (sECNT[e] + 143) / 144;
            for (int gt = 2 * vwg; gt < ctiles; gt += 2 * G)
            for (int kk = 0; kk < 2; ++kk) {
                const int ti = gt + kk; if (ti >= ctiles) break;
                int e = 0, j = ti;
                for (; e < 32; ++e) { const int n = (sECNT[e] + 143) / 144; if (j < n) break; j -= n; }
                const int cnt = sECNT[e], ne = (cnt + 143) / 144, re = (cnt + ne - 1) / ne, off = j * re, rows = min(re, cnt - off), nmf = (rows + 15) >> 4;
                __syncthreads();
                if (tid < 144) { const bool valid = tid < rows; const int slot = LIST[(size_t)e * 32768 + off + (valid ? tid : 0)];
                    sTOK[tid] = slot >> 1; sSLOT[tid] = valid ? slot : -1; sWT[tid] = SLOTW[slot]; sRV[tid] = RINVM[slot >> 1]; }
                __syncthreads();
                gemm_moe<false>(lds, ALGather{HB, 1024, sTOK}, WGU + (size_t)e * 512 * 1024, 1024, 2, nmf, [&](int nt, f32x4 (&acc)[9][2], int w, int l15, int q) {
#pragma unroll
                    for (int mf = 0; mf < 9; ++mf) { if (mf >= nmf) break; const int row = mf * 16 + l15; const float rv = sRV[row];
                        const f32x4 gt_ = acc[mf][0] * rv, up = acc[mf][1] * rv; f32x4 hd;
#pragma unroll
                        for (int r = 0; r < 4; ++r) hd[r] = gt_[r] * sigmoidf_(gt_[r]) * up[r];
                        { const int j0 = (nt * 8 + w) * 16 + 4 * q;
                          *(LAS u32x2*)(lds + MOE_HD + (j0 >> 7) * MOE_STG + row * 256 + (((((j0 & 127) >> 3)) ^ (row & 15)) << 4) + (j0 & 7) * 2) = pack4(hd); } }
                });
                gemm_moe<true>(lds, ALPlain{HB, 256}, WDN + (size_t)e * 1024 * 256, 256, 4, nmf, [&](int nt, f32x4 (&acc)[9][2], int w, int l15, int q) {
#pragma unroll
                    for (int mf = 0; mf < 9; ++mf) { if (mf >= nmf) break; const int row = mf * 16 + l15; const int slot = sSLOT[row]; const float wt = sWT[row];
                        if (slot >= 0) { const f32x4 a0 = acc[mf][0] * wt, a1 = acc[mf][1] * wt;
                            *(u32x2*)(YB8 + (size_t)slot * 1024 + nt * 256 + w * 32 + 8 * q) = (u32x2){y8enc(a0), y8enc(a1)}; } }
                });
                __syncthreads();
            }
        }
#endif
        if (L == 0 && !cvt_first) { PHASE_IDS(); const int gwave = wg * 8 + wid, nwaves = G * 8; __syncthreads();
        { const int L = 1;
            unsigned char* wl = ws + WS_W + (size_t)L * LAYER_W; const float* gmoe = (const float*)P.in[I_GMOE] + L * 1024;
            const float* weg = (const float*)P.in[I_WEG] + (size_t)L * 32 * 1024 * 256; const float* weu = (const float*)P.in[I_WEU] + (size_t)L * 32 * 1024 * 256;
            cvt_T(lds, 1024, 32 * 512, (bf16*)(wl + OW_GU), [&](int n, int) -> const float* { const int e = n >> 9, np = n & 511, blk = np >> 5, up = (np >> 4) & 1, j = np & 15;
                      return (up ? weu : weg) + (size_t)e * 1024 * 256 + blk * 16 + j; }, [&](int, int) { return 256; }, [&](int k) { return gmoe[k]; }, PermNone(), gwave, nwaves, lane, wid);
            const float* wed = (const float*)P.in[I_WED] + (size_t)L * 32 * 256 * 1024;
            cvt_T(lds, 256, 32 * 1024, (bf16*)(wl + OW_DN), [&](int n, int) -> const float* { return wed + (size_t)(n >> 10) * 256 * 1024 + (n & 1023); }, [&](int, int) { return 1024; }, [&](int) { return 1.f; }, PermAll(), gwave, nwaves, lane, wid);
        }
            __syncthreads(); }
        GRID_SYNC();

#if PH_MASK & 64
        for (int tile = wg; tile < NTILE; tile += G) {
            PHASE_IDS();
            const int R0 = tile * 128;
            bf16* PB = SCR;
            __syncthreads();
            for (int i = tid; i < 8 * 128; i += 512) SF(8)[i] = 0.f;
#pragma unroll 4
            for (int rr = 0; rr < 16; ++rr) { const int row = wid * 16 + rr; const size_t tok = R0 + row;
                const bf16* hp = HB + tok * 1024 + lane * 16; const unsigned char* y0 = YB8 + (2 * tok) * 1024 + lane * 16; bf16* op = HB2 + tok * 1024 + lane * 16;
                float ss = 0.f;
                const u32x4 a0 = *(const u32x4*)hp, a1 = *(const u32x4*)(hp + 8), b = *(const u32x4*)y0, c = *(const u32x4*)(y0 + 1024);
                float v[16];
#pragma unroll
                for (int i = 0; i < 4; ++i) { const f32x2 b0 = y8lo(b[i]), b1 = y8hi(b[i]), c0 = y8lo(c[i]), c1 = y8hi(c[i]);
                    const unsigned h0 = i < 2 ? a0[2 * i] : a1[2 * i - 4], h1 = i < 2 ? a0[2 * i + 1] : a1[2 * i - 3];
                    v[4 * i] = bflo(h0) + (b0[0] + c0[0]) * Y8_INV; v[4 * i + 1] = bfhi(h0) + (b0[1] + c0[1]) * Y8_INV; v[4 * i + 2] = bflo(h1) + (b1[0] + c1[0]) * Y8_INV; v[4 * i + 3] = bfhi(h1) + (b1[1] + c1[1]) * Y8_INV; }
#pragma unroll
                for (int i = 0; i < 16; ++i) ss += v[i] * v[i];
                *(u32x4*)op = (u32x4){cvtpk(v[0], v[1]), cvtpk(v[2], v[3]), cvtpk(v[4], v[5]), cvtpk(v[6], v[7])};
                *(u32x4*)(op + 8) = (u32x4){cvtpk(v[8], v[9]), cvtpk(v[10], v[11]), cvtpk(v[12], v[13]), cvtpk(v[14], v[15])};
#pragma unroll
                for (int o = 1; o < 64; o <<= 1) ss += __shfl_xor(ss, o);
                if (lane == 0) SF(0)[row] = rsqrtf(ss * (1.f / 1024.f) + EPS);
            }
            BLOCK_SEAM();
            LAS u32x2* STASH = (LAS u32x2*)(lds + LDS_B0);
            gemm_rows<2, true>(lds, ALF32Two{(const float*)P.in[I_P] + ((size_t)L * T + R0) * 256, 256, 256, HB2 + (size_t)R0 * 1024, 1024}, WPGC, 1280, 4, 8, [&](int nt, f32x4 (&acc)[8][2], int w, int l15, int q) {
#pragma unroll
                for (int mf = 0; mf < 8; ++mf) { const int row = mf * 16 + l15; const size_t tok = R0 + row; const float rv = SF(0)[row]; float ss = 0.f;
                    const int col = nt * 256 + w * 32 + 8 * q; const u32x4 hw = *(const u32x4*)(HB2 + tok * 1024 + col);
                    const f32x4 h20 = unpack4((u32x2){hw.x, hw.y}), h21 = unpack4((u32x2){hw.z, hw.w}), pp0 = unpack4(STASH[((w * 8 + mf) * 2 + 0) * 64 + q * 16 + l15]), pp1 = unpack4(STASH[((w * 8 + mf) * 2 + 1) * 64 + q * 16 + l15]);
                    f32x4 v0, v1;
#pragma unroll
                    for (int r = 0; r < 4; ++r) { v0[r] = h20[r] + pp0[r] * sigmoidf_(acc[mf][0][r] * rv); v1[r] = h21[r] + pp1[r] * sigmoidf_(acc[mf][1][r] * rv); ss += v0[r] * v0[r] + v1[r] * v1[r]; }
                    *(u32x4*)(HB + tok * 1024 + col) = pack8(v0, v1);
                    ss += __shfl_xor(ss, 16); ss += __shfl_xor(ss, 32);
                    if (q == 0) SF(8 + w)[row] += ss; }
            }, true, false, 1, [&](f32x4 (&acc)[8][2], int w, int l15, int q) {
#pragma unroll
                for (int mf = 0; mf < 8; ++mf)
#pragma unroll
                    for (int nf = 0; nf < 2; ++nf) { STASH[((w * 8 + mf) * 2 + nf) * 64 + q * 16 + l15] = pack4(acc[mf][nf]); acc[mf][nf] = (f32x4){0.f, 0.f, 0.f, 0.f}; }
            });
            BLOCK_SEAM();
            if (tid < 128) SF(2)[tid] = ((SF(8)[tid] + SF(9)[tid]) + (SF(10)[tid] + SF(11)[tid])) + ((SF(12)[tid] + SF(13)[tid]) + (SF(14)[tid] + SF(15)[tid]));
            __syncthreads();
            if (L + 1 < DEPTH) { if (tid < 128) ROWSS[R0 + tid] = SF(2)[tid]; }
            else {
                const float* gf = (const float*)P.in[I_GFIN];
                const f32x4 g0 = *(const f32x4*)(gf + lane * 8), g1 = *(const f32x4*)(gf + lane * 8 + 4), g2 = *(const f32x4*)(gf + 512 + lane * 8), g3 = *(const f32x4*)(gf + 512 + lane * 8 + 4);
#pragma unroll 4
                for (int rr = 0; rr < 16; ++rr) { const int row = wid * 16 + rr; const size_t tok = R0 + row;
                    const float rv = rsqrtf(SF(2)[row] * (1.f / 1024.f) + EPS);
                    const u32x4 a = *(const u32x4*)(HB + tok * 1024 + lane * 8), c = *(const u32x4*)(HB + tok * 1024 + 512 + lane * 8); float* op = P.out + tok * 1024 + lane * 8;
                    *(f32x4*)op = (f32x4){bflo(a.x) * rv * g0[0], bfhi(a.x) * rv * g0[1], bflo(a.y) * rv * g0[2], bfhi(a.y) * rv * g0[3]};
                    *(f32x4*)(op + 4) = (f32x4){bflo(a.z) * rv * g1[0], bfhi(a.z) * rv * g1[1], bflo(a.w) * rv * g1[2], bfhi(a.w) * rv * g1[3]};
                    *(f32x4*)(op + 512) = (f32x4){bflo(c.x) * rv * g2[0], bfhi(c.x) * rv * g2[1], bflo(c.y) * rv * g2[2], bfhi(c.y) * rv * g2[3]};
                    *(f32x4*)(op + 516) = (f32x4){bflo(c.z) * rv * g3[0], bfhi(c.z) * rv * g3[1], bflo(c.w) * rv * g3[2], bfhi(c.w) * rv * g3[3]}; }
            }
            BLOCK_SEAM();
        }
#endif
        if (L + 1 < DEPTH) { VM_WAIT(); __syncthreads(); if (threadIdx.x == 0) (void)xb_add(ctl + CW_XL, 1u); }
    }
}

extern "C" void kernel_launch(void* const* d_in, const int* in_sizes, int n_in, void* d_out, int out_size, void* d_ws, size_t ws_size, hipStream_t stream) {
    static int grid = 0;
    if (grid == 0) {
        if (n_in != 34 || out_size != T * DM || ws_size < WS_END) { fprintf(stderr, "kernel_launch: unexpected problem (n_in %d out %d ws %zu)\n", n_in, out_size, ws_size); grid = -1; return; }
        int dev = 0, cus = 0, per_cu = 0;
        (void)hipGetDevice(&dev);
        (void)hipDeviceGetAttribute(&cus, hipDeviceAttributeMultiprocessorCount, dev);
        if (hipFuncSetAttribute((const void*)mk_fwd, hipFuncAttributeMaxDynamicSharedMemorySize, LDS_TOTAL) != hipSuccess) { fprintf(stderr, "kernel_launch: hipFuncSetAttribute failed\n"); grid = -1; return; }
        if (hipOccupancyMaxActiveBlocksPerMultiprocessor(&per_cu, (const void*)mk_fwd, 512, LDS_TOTAL) != hipSuccess || per_cu < 1) { fprintf(stderr, "kernel_launch: occupancy query says %d blocks/CU\n", per_cu); (void)hipGetLastError(); per_cu = per_cu < 1 ? 0 : per_cu; }
        if (per_cu < 1 || cus < 1) { grid = -1; return; }
        grid = cus < NTILE ? cus : NTILE;
    }
    if (grid < 0) return;
    (void)hipMemsetAsync((char*)d_ws + WS_CTL, 0, CTL_BYTES, stream);
    Params p{};
    for (int i = 0; i < 34; ++i) p.in[i] = d_in[i];
    p.out = (float*)d_out; p.ws = (unsigned char*)d_ws;
    hipLaunchKernelGGL(mk_fwd, dim3(grid), dim3(512), LDS_TOTAL, stream, p);
}
```
